# Optimizing an MI355X kernel written in HIP

```python
import jax, jax.numpy as jnp
from jax import lax
import numpy as np

D_MODEL = 1024
BATCH = 8
SEQ = 4096
DEPTH = 2

CTX_LEN = 256
GRID_W = 64
HEAD_DIM = 64
AXIS_DIM = HEAD_DIM // 2
ATTN_WIDTH = D_MODEL // 2
N_Q_HEADS = ATTN_WIDTH // HEAD_DIM
N_KV_HEADS = N_Q_HEADS // 4
KV_WIDTH = N_KV_HEADS * HEAD_DIM
FOURIER_WIDTH = D_MODEL // 4
FOURIER_GROUP = 64
N_FOURIER_GROUPS = FOURIER_WIDTH // FOURIER_GROUP
GMLP_WIDTH = D_MODEL // 4
GMLP_HEAD = 64
N_GMLP_HEADS = GMLP_WIDTH // GMLP_HEAD
CHUNK = 128
Q_BLOCK = 128
MIX_WIDTH = ATTN_WIDTH + FOURIER_WIDTH + GMLP_WIDTH
IN_WIDTH = ATTN_WIDTH + 2 * KV_WIDTH + FOURIER_WIDTH + 2 * GMLP_WIDTH
SPLITS = [ATTN_WIDTH, ATTN_WIDTH + KV_WIDTH, ATTN_WIDTH + 2 * KV_WIDTH,
          ATTN_WIDTH + 2 * KV_WIDTH + FOURIER_WIDTH,
          ATTN_WIDTH + 2 * KV_WIDTH + FOURIER_WIDTH + GMLP_WIDTH]
D_FF = 4 * D_MODEL
ROPE_THETA = 10000.0
EPS = 1e-6

kernel_name = 'hybrid_fourier_gmlp_gqa_prefix_dit'


def rms_norm(x, g):
    xf = x.astype(jnp.float32)
    y = xf * lax.rsqrt(jnp.mean(xf * xf, axis=-1, keepdims=True) + EPS)
    return (y * g.astype(jnp.float32)).astype(x.dtype)


def modulate(h, shift, scale):
    return h * (1 + scale) + shift


def adaln(cond, w, b):
    return jnp.split(jax.nn.silu(cond) @ w + b, 6, axis=-1)


def axial_rope_tables(n, dtype):
    rows = n // GRID_W
    row = jnp.repeat(jnp.arange(rows, dtype=jnp.float32), GRID_W)
    col = jnp.tile(jnp.arange(GRID_W, dtype=jnp.float32), rows)
    inv = ROPE_THETA ** (-jnp.arange(0, AXIS_DIM, 2, dtype=jnp.float32) / AXIS_DIM)
    ar = (row[:, None] * inv)[:, None, :]
    ac = (col[:, None] * inv)[:, None, :]
    return tuple(t.astype(dtype) for t in (jnp.cos(ar), jnp.sin(ar), jnp.cos(ac), jnp.sin(ac)))


def rope_1d(x, cos, sin):
    x1, x2 = jnp.split(x, 2, axis=-1)
    return jnp.concatenate([x1 * cos - x2 * sin, x1 * sin + x2 * cos], axis=-1)


def apply_axial_rope(x, tabs):
    cr, sr, cc, sc = tabs
    xr, xc = jnp.split(x, 2, axis=-1)
    return jnp.concatenate([rope_1d(xr, cr, sr), rope_1d(xc, cc, sc)], axis=-1)


def heads(t, h):
    return t.reshape(t.shape[0], t.shape[1], h, HEAD_DIM)


def attend(q, k, v):
    s = jnp.einsum('bqkgd,btkd->bkgqt', q, k).astype(jnp.float32) * (HEAD_DIM ** -0.5)
    p = jax.nn.softmax(s, axis=-1).astype(v.dtype)
    return jnp.einsum('bkgqt,btkd->bqkgd', p, v)


def latent_attention(q, k, v):
    b, s, hq, d = q.shape
    g = hq // N_KV_HEADS
    nblk = s // Q_BLOCK
    qb = q.reshape(b, nblk, Q_BLOCK, N_KV_HEADS, g, d).transpose(1, 0, 2, 3, 4, 5)
    out = lax.map(lambda qblk: attend(qblk, k, v), qb)
    return out.transpose(1, 0, 2, 3, 4, 5).reshape(b, s, hq * d)


def context_attention(q, k, v):
    b, n, hq, d = q.shape
    g = hq // N_KV_HEADS
    return attend(q.reshape(b, n, N_KV_HEADS, g, d), k, v).reshape(b, n, hq * d)


def fourier_mix(f):
    b, n, _ = f.shape
    fg = f.astype(jnp.float32).reshape(b, n, N_FOURIER_GROUPS, FOURIER_GROUP)
    y = jnp.fft.fft2(fg, axes=(1, 3), norm='ortho').real
    return y.reshape(b, n, FOURIER_WIDTH).astype(f.dtype)


def chunk_spatial_gate(u, v, v_g, w_s, b_s):
    b, n, _ = u.shape
    u = jax.nn.gelu(u)
    vh = jax.nn.gelu(v).reshape(b, n // CHUNK, CHUNK, N_GMLP_HEADS, GMLP_HEAD)
    vh = rms_norm(vh, v_g.reshape(N_GMLP_HEADS, GMLP_HEAD))
    sp = jnp.einsum('hpq,bcqhd->bcphd', w_s, vh) + b_s.T[None, None, :, :, None]
    return u * sp.reshape(b, n, GMLP_WIDTH)


def squared_relu_mlp(h, w1, w2):
    return jnp.square(jax.nn.relu(h @ w1)) @ w2


def layer(x, ctx, c, c_ctx, w_ada, b_ada, g1, g2, w_in, q_g, k_g, v_g, w_s, b_s, w_out, w1, w2, update_ctx):
    sh1, sc1, gt1, sh2, sc2, gt2 = [m[:, None, :] for m in adaln(c, w_ada, b_ada)]
    csh1, csc1, cgt1, csh2, csc2, cgt2 = adaln(c_ctx, w_ada, b_ada)

    px = modulate(rms_norm(x, g1), sh1, sc1) @ w_in
    pc = modulate(rms_norm(ctx, g1), csh1, csc1) @ w_in
    qx, kx, vx, fx, ux, gvx = jnp.split(px, SPLITS, axis=-1)
    qc, kc, vc, fc, uc, gvc = jnp.split(pc, SPLITS, axis=-1)

    tabs = axial_rope_tables(x.shape[1], x.dtype)
    qx = apply_axial_rope(rms_norm(heads(qx, N_Q_HEADS), q_g), tabs)
    kx = apply_axial_rope(rms_norm(heads(kx, N_KV_HEADS), k_g), tabs)
    kc = rms_norm(heads(kc, N_KV_HEADS), k_g)
    vx = heads(vx, N_KV_HEADS)
    vc = heads(vc, N_KV_HEADS)
    k_all = jnp.concatenate([kc, kx], axis=1)
    v_all = jnp.concatenate([vc, vx], axis=1)

    mix_x = jnp.concatenate([latent_attention(qx, k_all, v_all),
                             fourier_mix(fx),
                             chunk_spatial_gate(ux, gvx, v_g, w_s, b_s)], axis=-1) @ w_out
    x = x + gt1 * mix_x
    x = x + gt2 * squared_relu_mlp(modulate(rms_norm(x, g2), sh2, sc2), w1, w2)

    if update_ctx:
        qc = rms_norm(heads(qc, N_Q_HEADS), q_g)
        mix_c = jnp.concatenate([context_attention(qc, kc, vc),
                                 fourier_mix(fc),
                                 chunk_spatial_gate(uc, gvc, v_g, w_s, b_s)], axis=-1) @ w_out
        ctx = ctx + cgt1 * mix_c
        ctx = ctx + cgt2 * squared_relu_mlp(modulate(rms_norm(ctx, g2), csh2, csc2), w1, w2)
    return x, ctx


def setup_inputs(seed: int = 0) -> dict:
    key = jax.random.key(seed)
    ks = jax.random.split(key, 17)
    f32 = jnp.float32
    n = lambda k, s: jax.random.normal(k, s, dtype=f32)
    return {
        'x': n(ks[0], (BATCH, SEQ, D_MODEL)),
        'c': n(ks[1], (BATCH, D_MODEL)),
        'ctx': n(ks[2], (BATCH, CTX_LEN, D_MODEL)),
        'c_ctx': n(ks[3], (D_MODEL,)),
        'w_ada': n(ks[4], (DEPTH, D_MODEL, 6 * D_MODEL)) * (0.5 * D_MODEL ** -0.5),
        'b_ada': n(ks[5], (DEPTH, 6 * D_MODEL)) * 0.01,
        'norm1_g': 1.0 + 0.02 * n(ks[6], (DEPTH, D_MODEL)),
        'norm2_g': 1.0 + 0.02 * n(ks[7], (DEPTH, D_MODEL)),
        'w_in': n(ks[8], (DEPTH, D_MODEL, IN_WIDTH)) * D_MODEL ** -0.5,
        'q_norm_g': 1.0 + 0.02 * n(ks[9], (DEPTH, HEAD_DIM)),
        'k_norm_g': 1.0 + 0.02 * n(ks[10], (DEPTH, HEAD_DIM)),
        'gmlp_v_g': 1.0 + 0.02 * n(ks[11], (DEPTH, GMLP_WIDTH)),
        'w_spatial': n(ks[12], (DEPTH, N_GMLP_HEADS, CHUNK, CHUNK)) * CHUNK ** -0.5,
        'b_spatial': n(ks[13], (DEPTH, N_GMLP_HEADS, CHUNK)) * 0.02,
        'w_out': n(ks[14], (DEPTH, MIX_WIDTH, D_MODEL)) * MIX_WIDTH ** -0.5,
        'w_mlp1': n(ks[15], (DEPTH, D_MODEL, D_FF)) * D_MODEL ** -0.5,
        'w_mlp2': n(ks[16], (DEPTH, D_FF, D_MODEL)) * D_FF ** -0.5,
    }


def reference(x, c, ctx, c_ctx, w_ada, b_ada, norm1_g, norm2_g, w_in, q_norm_g, k_norm_g, gmlp_v_g,
              w_spatial, b_spatial, w_out, w_mlp1, w_mlp2):
    for l in range(DEPTH):
        x, ctx = layer(x, ctx, c, c_ctx, w_ada[l], b_ada[l], norm1_g[l], norm2_g[l], w_in[l],
                       q_norm_g[l], k_norm_g[l], gmlp_v_g[l], w_spatial[l], b_spatial[l], w_out[l],
                       w_mlp1[l], w_mlp2[l], l < DEPTH - 1)
    return x
```

```cpp
#include <hip/hip_runtime.h>
#include <hip/hip_cooperative_groups.h>
#include <cstdio>
#include <cstdint>
namespace cg = cooperative_groups;
namespace pg8 {
#define PG8_LAS __attribute__((address_space(3)))
typedef unsigned short bf16_t;
typedef short bf16x8 __attribute__((ext_vector_type(8)));
typedef float f32x4 __attribute__((ext_vector_type(4)));
typedef unsigned u32x4 __attribute__((ext_vector_type(4)));
constexpr int BM = 256, BK = 64, HALF = 128, HTB = HALF * BK * 2  , STAGE_BYTES = 8 * HTB, NXCD = 8, WGM = 8;

__host__ __device__ __forceinline__ int lds_byte(int r, int c) { const int st = (r >> 4) * 2 + (c >> 5), rr = r & 15, cc = c & 31, ob = rr * 64 + cc * 2; return st * 1024 + (ob ^ (((ob >> 9) & 1) << 5)); }
__host__ __device__ __forceinline__ void stage_rc(int b, int& R, int& C) { const int st = b / 1024, sb = b % 1024, swz = sb ^ (((sb >> 9) & 1) << 5); R = (st >> 1) * 16 + swz / 64; C = (st & 1) * 32 + (swz % 64) / 2; }
__host__ __device__ __forceinline__ int perm32(int rho) { const int n = rho >> 4, i = rho & 15; return 8 * (i >> 2) + 4 * n + (i & 3); }

struct Unit { int pm, pn; };
struct Gemm { const bf16_t* A; const bf16_t* Bt; int M, N, K; int ld; };

struct StaticOrder {
    int nM, nN, nwg, G, c;
    __host__ __device__ void init(int M, int N, int G_, int c_) { nM = M / BM; nN = N / BM; nwg = nM * nN; G = G_; c = c_; }
    __host__ __device__ bool next(int i, Unit& u) const {
        const long L = (long)i * G + c; if (L >= nwg) return false;
        int wgid = (int)L; { const int q = nwg / NXCD, r = nwg % NXCD, xcd = wgid % NXCD, off = wgid / NXCD; wgid = (xcd < r ? xcd * (q + 1) : r * (q + 1) + (xcd - r) * q) + off; }
        const int nig = WGM * nN, gid = wgid / nig, fm = gid * WGM, gsz = (nM - fm) < WGM ? (nM - fm) : WGM;
        u.pm = fm + ((wgid % nig) % gsz); u.pn = (wgid % nig) / gsz; return true;
    }
    __device__ __forceinline__ void a_ready(const Unit&) const {}
    __device__ __forceinline__ void done(const Unit&) const {}
};

__device__ __forceinline__ unsigned cvt_pk_bf16(float lo, float hi) { unsigned r; asm volatile("v_cvt_pk_bf16_f32 %0, %1, %2" : "=v"(r) : "v"(lo), "v"(hi)); return r; }
typedef float f32x2 __attribute__((ext_vector_type(2)));
template <class Epi, class Sched, bool ALIGN_EPI = false, bool SP2 = false>
__device__ __forceinline__ void gemm_phase(PG8_LAS unsigned char* lds, const Gemm g, const Sched& S, const Epi& E) {
    int tid_ = threadIdx.x; asm volatile("" : "+v"(tid_)); const int tid = tid_, wid = __builtin_amdgcn_readfirstlane(tid >> 6), lane = tid & 63, wr = wid >> 2, wc = wid & 3, fr = lane & 15, fq = lane >> 4;
    const int K = g.K, nt = K / BK, LD = g.ld ? g.ld : g.K;
    unsigned voffA[2], voffB[2];
#pragma unroll
    for (int i = 0; i < 2; ++i) { int R, C; stage_rc(tid * 16 + i * 8192, R, C); const int Rb = Epi::PERM ? ((R & ~31) + perm32(R & 31)) : R;
        voffA[i] = (unsigned)(R * LD + C) * 2u; voffB[i] = (unsigned)(Rb * LD + C) * 2u; }
    const size_t kstep = (size_t)(BK * 2);
    const size_t hstep = (size_t)HALF * LD * 2;
    const size_t tstep = 2 * hstep;
    const unsigned ldsw = (unsigned)wid * 1024u;
    const int aoff = lds_byte(wr * 64 + fr, fq * 8), boff = lds_byte(wc * 32 + fr, fq * 8);
#define PG8_SA(b, h) (((b) * 2 + (h)) * HTB)
#define PG8_SB(b, h) ((4 + (b) * 2 + (h)) * HTB)
#define PG8_STAGE(bufoff, gbase, voff) do { _Pragma("unroll") for (int _i = 0; _i < 2; ++_i) \
        __builtin_amdgcn_global_load_lds((const unsigned*)((const char*)(gbase) + (voff)[_i]), (PG8_LAS unsigned*)(lds + (bufoff) + ldsw + _i * 8192), 16, 0, 0); } while (0)
#define PG8_LDA(dst, b, h) do { _Pragma("unroll") for (int m = 0; m < 4; ++m) _Pragma("unroll") for (int k = 0; k < 2; ++k) dst[m][k] = *(const PG8_LAS bf16x8*)(lds + PG8_SA(b, h) + aoff + m * 2048 + k * 1024); } while (0)
#define PG8_LDB(dst, b, h) do { _Pragma("unroll") for (int n = 0; n < 2; ++n) _Pragma("unroll") for (int k = 0; k < 2; ++k) dst[n][k] = *(const PG8_LAS bf16x8*)(lds + PG8_SB(b, h) + boff + n * 2048 + k * 1024); } while (0)
#define PG8_MMA(ai, bj, At, Bt) do { __builtin_amdgcn_s_setprio(1); _Pragma("unroll") for (int m = 0; m < 4; ++m) _Pragma("unroll") for (int n = 0; n < 2; ++n) _Pragma("unroll") for (int k = 0; k < 2; ++k) \
        acc[ai][bj][m][n] = __builtin_amdgcn_mfma_f32_16x16x32_bf16(Bt[n][k], At[m][k], acc[ai][bj][m][n], 0, 0, 0); __builtin_amdgcn_s_setprio(0); } while (0)
#define PG8_WAIT_V(n) asm volatile("s_waitcnt vmcnt(" #n ")" ::: "memory")
#define PG8_WAIT_L(n) asm volatile("s_waitcnt lgkmcnt(" #n ")" ::: "memory")
#define PG8_BAR __builtin_amdgcn_s_barrier()
#define PG8_SCHED __builtin_amdgcn_sched_barrier(0)
    Unit cur, nxt; int ui = 0;
    if (!S.next(0, cur)) return;
    f32x4 acc[2][2][4][2];
#pragma unroll
    for (int a = 0; a < 2; ++a)
#pragma unroll
        for (int b = 0; b < 2; ++b)
#pragma unroll
            for (int m = 0; m < 4; ++m)
#pragma unroll
                for (int n = 0; n < 2; ++n) acc[a][b][m][n] = (f32x4){0.f, 0.f, 0.f, 0.f};
    bf16x8 At[4][2], B0[2][2], B1[2][2];
    const char* cA = (const char*)g.A + (size_t)cur.pm * tstep; const char* cB = (const char*)g.Bt + (size_t)cur.pn * tstep;
    S.a_ready(cur);
    if constexpr (SP2) {
        PG8_STAGE(PG8_SB(0, 0), cB, voffB); PG8_STAGE(PG8_SB(0, 1), cB + hstep, voffB); PG8_STAGE(PG8_SA(0, 0), cA, voffA); PG8_STAGE(PG8_SA(0, 1), cA + hstep, voffA);
        if (wr == 1) PG8_BAR;
        PG8_WAIT_V(2); PG8_BAR;
        PG8_STAGE(PG8_SB(1, 0), cB + kstep, voffB); PG8_STAGE(PG8_SA(1, 0), cA + kstep, voffA); PG8_STAGE(PG8_SB(1, 1), cB + hstep + kstep, voffB);
        PG8_WAIT_V(6); PG8_BAR;
    } else {
        PG8_STAGE(PG8_SB(0, 0), cB, voffB); PG8_STAGE(PG8_SA(0, 0), cA, voffA); PG8_STAGE(PG8_SB(0, 1), cB + hstep, voffB); PG8_STAGE(PG8_SA(0, 1), cA + hstep, voffA);
        if (wr == 1) PG8_BAR;
        PG8_WAIT_V(4); PG8_BAR;
        PG8_STAGE(PG8_SB(1, 0), cB + kstep, voffB); PG8_STAGE(PG8_SA(1, 0), cA + kstep, voffA); PG8_STAGE(PG8_SB(1, 1), cB + hstep + kstep, voffB);
        PG8_WAIT_V(6); PG8_BAR;
    }
    for (;;) {
        const bool has_next = S.next(ui + 1, nxt);
        const char* nA = has_next ? (const char*)g.A + (size_t)nxt.pm * tstep : cA; const char* nB = has_next ? (const char*)g.Bt + (size_t)nxt.pn * tstep : cB;
        for (int t = 0; t < nt; t += 2) {
            const bool last = (t == nt - 2);
            const char* a1 = cA + (size_t)(t + 1) * kstep;
            const char* a2 = last ? nA : cA + (size_t)(t + 2) * kstep; const char* b2 = last ? nB : cB + (size_t)(t + 2) * kstep;
            const char* a3 = a2 + kstep; const char* b3 = b2 + kstep;
            if (last && has_next) S.a_ready(nxt);
            if constexpr (SP2) {
            PG8_LDB(B0, 0, 0); PG8_LDB(B1, 0, 1); PG8_SCHED; PG8_LDA(At, 0, 0); PG8_STAGE(PG8_SA(1, 1), a1 + hstep, voffA);
            PG8_WAIT_V(8); PG8_WAIT_L(0); PG8_BAR; PG8_MMA(0, 0, At, B0); PG8_MMA(0, 1, At, B1); PG8_BAR; PG8_SCHED;
            PG8_LDA(At, 0, 1); PG8_STAGE(PG8_SB(0, 0), b2, voffB); PG8_STAGE(PG8_SB(0, 1), b2 + hstep, voffB); PG8_STAGE(PG8_SA(0, 0), a2, voffA);
            PG8_WAIT_V(8); PG8_WAIT_L(0); PG8_BAR; PG8_MMA(1, 0, At, B0); PG8_MMA(1, 1, At, B1); PG8_BAR; PG8_SCHED;
            PG8_LDB(B0, 1, 0); PG8_LDB(B1, 1, 1); PG8_SCHED; PG8_LDA(At, 1, 0); PG8_STAGE(PG8_SA(0, 1), a2 + hstep, voffA);
            PG8_WAIT_V(8); PG8_WAIT_L(0); PG8_BAR; PG8_MMA(0, 0, At, B0); PG8_MMA(0, 1, At, B1); PG8_BAR; PG8_SCHED;
            PG8_LDA(At, 1, 1); PG8_STAGE(PG8_SB(1, 0), b3, voffB); PG8_STAGE(PG8_SB(1, 1), b3 + hstep, voffB); PG8_STAGE(PG8_SA(1, 0), a3, voffA);
            PG8_WAIT_V(8); PG8_WAIT_L(0); PG8_BAR; PG8_MMA(1, 0, At, B0); PG8_MMA(1, 1, At, B1); PG8_BAR; PG8_SCHED;
            } else {
            PG8_LDB(B0, 0, 0); PG8_SCHED; PG8_LDA(At, 0, 0); PG8_STAGE(PG8_SA(1, 1), a1 + hstep, voffA);
            PG8_WAIT_L(8); PG8_BAR; PG8_WAIT_L(0); PG8_MMA(0, 0, At, B0); PG8_BAR; PG8_SCHED;
            PG8_LDB(B1, 0, 1); PG8_STAGE(PG8_SB(0, 0), b2, voffB);
            PG8_BAR; PG8_WAIT_L(0); PG8_MMA(0, 1, At, B1); PG8_BAR;
            PG8_LDA(At, 0, 1); PG8_STAGE(PG8_SA(0, 0), a2, voffA);
            PG8_BAR; PG8_WAIT_L(0); PG8_MMA(1, 0, At, B0); PG8_BAR; PG8_SCHED;
            PG8_STAGE(PG8_SB(0, 1), b2 + hstep, voffB);
            PG8_WAIT_V(6); PG8_BAR; PG8_MMA(1, 1, At, B1); PG8_BAR;
            PG8_LDB(B0, 1, 0); PG8_SCHED; PG8_LDA(At, 1, 0); PG8_STAGE(PG8_SA(0, 1), a2 + hstep, voffA);
            PG8_WAIT_L(8); PG8_BAR; PG8_WAIT_L(0); PG8_MMA(0, 0, At, B0); PG8_BAR; PG8_SCHED;
            PG8_LDB(B1, 1, 1); PG8_STAGE(PG8_SB(1, 0), b3, voffB);
            PG8_BAR; PG8_WAIT_L(0); PG8_MMA(0, 1, At, B1); PG8_BAR;
            PG8_LDA(At, 1, 1); PG8_STAGE(PG8_SA(1, 0), a3, voffA);
            PG8_BAR; PG8_WAIT_L(0); PG8_MMA(1, 0, At, B0); PG8_BAR; PG8_SCHED;
            PG8_STAGE(PG8_SB(1, 1), b3 + hstep, voffB);
            PG8_WAIT_V(6); PG8_BAR; PG8_MMA(1, 1, At, B1); PG8_BAR;
            }
        }
        if constexpr (ALIGN_EPI) { if (wr == 0) PG8_BAR; }
        if constexpr (!Epi::AFTER_DRAIN) { E(acc, cur, wr, wc, fr, fq); S.done(cur); }
        if (!has_next) break;
#pragma unroll
        for (int a = 0; a < 2; ++a)
#pragma unroll
            for (int b = 0; b < 2; ++b)
#pragma unroll
                for (int m = 0; m < 4; ++m)
#pragma unroll
                    for (int n = 0; n < 2; ++n) acc[a][b][m][n] = (f32x4){0.f, 0.f, 0.f, 0.f};
        cur = nxt; cA = nA; cB = nB; ++ui;
        if constexpr (ALIGN_EPI) { if (wr == 1) PG8_BAR; }
    }
    PG8_WAIT_V(0);
    if constexpr (!ALIGN_EPI) { if (wr == 0) PG8_BAR; }
    PG8_BAR;
    if constexpr (Epi::AFTER_DRAIN) { E.fused(acc, cur, wr, wc, fr, fq, lds, wid, lane); S.done(cur); }
#undef PG8_SA
#undef PG8_SB
#undef PG8_STAGE
#undef PG8_LDA
#undef PG8_LDB
#undef PG8_MMA
#undef PG8_WAIT_V
#undef PG8_WAIT_L
#undef PG8_BAR
#undef PG8_SCHED
}
}

#define LAS __attribute__((address_space(3)))
#define GAS __attribute__((address_space(1)))
using pg8::bf16_t; using pg8::f32x4; using pg8::bf16x8;
typedef float f32x16 __attribute__((ext_vector_type(16)));
typedef float f32x2v __attribute__((ext_vector_type(2)));
typedef __bf16 bf16x2v __attribute__((ext_vector_type(2)));
typedef unsigned u32x4 __attribute__((ext_vector_type(4)));
typedef unsigned u32x2 __attribute__((ext_vector_type(2)));

#ifndef REP_PREP
#define REP_PREP 1
#endif
#ifndef PREP_PROBE_MASK
#define PREP_PROBE_MASK 31
#endif
#ifndef REP_POST
#define REP_POST 1
#endif
#ifndef REP_ATTN
#define REP_ATTN 1
#endif
#ifndef REP_NORM
#define REP_NORM 1
#endif
#ifndef REP_FOUR
#define REP_FOUR 1
#endif
#ifndef REP_BAR
#define REP_BAR 1
#endif
constexpr int NTHREADS = 512;
constexpr int LDS_BYTES = 147456;
constexpr int NB = 8, SEQ = 4096, DM = 1024, CTX = 256, TKV = SEQ + CTX;
constexpr int MX = NB * SEQ, MC = NB * CTX, MT = MX + MC;
constexpr int NIN = 1792, KOUT = 1024, DFF = 4096;
constexpr size_t MiB = 1u << 20;
constexpr size_t WS_CTL = 0, WS_MOD = 1 * MiB, WS_ROPE = 2 * MiB, WS_WIN = 4 * MiB, WS_WOUT = 12 * MiB, WS_W1 = 18 * MiB, WS_W2 = 34 * MiB,
                 WS_CT = 50 * MiB, WS_ST = 82 * MiB, WS_CTC = 114 * MiB, WS_WSB = 115 * MiB, WS_XC = 116 * MiB, WS_A1 = 124 * MiB,
                 WS_PX = 192 * MiB, WS_QS = 311 * MiB, WS_KS = 345 * MiB, WS_VT = 354 * MiB, WS_ZT = 363 * MiB, WS_ZTC = 395 * MiB,
                 WS_MIX = 397 * MiB, WS_H = 192 * MiB, WS_END = 482 * MiB,
                 WS_FA = 50 * MiB, WS_FB = 51 * MiB, WS_TW = 52 * MiB, WS_GS = 53 * MiB, WS_SHW = 54 * MiB, WS_RS = 55 * MiB, WS_SLAB = 58 * MiB;
constexpr float QSCALE = 0.125f * 1.4426950408889634f;

struct Params {
    const float *x, *c, *ctx, *cctx, *w_ada, *b_ada, *g1, *g2, *w_in, *qg, *kg, *vg, *wsp, *bsp, *w_out, *w1, *w2;
    float* out; unsigned char* ws;
};

__device__ __forceinline__ unsigned pk2(float lo, float hi) { f32x2v v = {lo, hi}; bf16x2v b = __builtin_convertvector(v, bf16x2v); return __builtin_bit_cast(unsigned, b); }
__device__ __forceinline__ unsigned short f2bf(float f) { return (unsigned short)(pk2(f, 0.f) & 0xffffu); }
__device__ __forceinline__ float bf2f(unsigned short h) { return __uint_as_float(((unsigned)h) << 16); }
__device__ __forceinline__ float gelu_t(float x) { const float t = x * (-2.3022082f + -0.10294324f * x * x); return x * __builtin_amdgcn_rcpf(1.0f + __builtin_amdgcn_exp2f(t)); }
__device__ __forceinline__ void unpack8(const u32x4 v, float (&y)[8]) {
    y[0] = __uint_as_float(v.x << 16); y[1] = __uint_as_float(v.x & 0xffff0000u); y[2] = __uint_as_float(v.y << 16); y[3] = __uint_as_float(v.y & 0xffff0000u);
    y[4] = __uint_as_float(v.z << 16); y[5] = __uint_as_float(v.z & 0xffff0000u); y[6] = __uint_as_float(v.w << 16); y[7] = __uint_as_float(v.w & 0xffff0000u);
}
__device__ __forceinline__ float dpp_xor1(float v) { return __builtin_bit_cast(float, __builtin_amdgcn_update_dpp(0, __builtin_bit_cast(int, v), 0xB1, 0xF, 0xF, true)); }
__device__ __forceinline__ float dpp_xor2(float v) { return __builtin_bit_cast(float, __builtin_amdgcn_update_dpp(0, __builtin_bit_cast(int, v), 0x4E, 0xF, 0xF, true)); }
__device__ __forceinline__ float dpp_mirror8(float v) { return __builtin_bit_cast(float, __builtin_amdgcn_update_dpp(0, __builtin_bit_cast(int, v), 0x141, 0xF, 0xF, true)); }
__device__ __forceinline__ float sum8(float s) { s += dpp_xor1(s); s += dpp_xor2(s); s += dpp_mirror8(s); return s; }
__device__ __forceinline__ float wave_sum(float v) {
#pragma unroll
    for (int o = 1; o < 64; o <<= 1) v += __shfl_xor(v, o);
    return v;
}

#define XB_TMO      128
#define XB_XCNT(j)  (256  + 64 * (j))
#define XB_XSUB(j)  (1280 + 64 * (j))
#define XB_XGEN(j)  (2304 + 64 * (j))
#define XB_TOP      3328
#define XB_TOPGEN   3392
#define XCD_BAR_WORDS 3456
#define XB_SPIN_CAP (1u << 18)

__device__ __forceinline__ unsigned xb_ld(unsigned* p)              { return __hip_atomic_load(p, __ATOMIC_RELAXED, __HIP_MEMORY_SCOPE_AGENT); }
__device__ __forceinline__ unsigned xb_add(unsigned* p, unsigned v) { return __hip_atomic_fetch_add(p, v, __ATOMIC_RELAXED, __HIP_MEMORY_SCOPE_AGENT); }
__device__ __forceinline__ unsigned xb_xcc_id() { return (unsigned)__builtin_amdgcn_s_getreg((3 << 11) | 20) & 0xFu; }
#define XB_SPIN(cond, bar) do { unsigned _sp = 0; while (cond) { __builtin_amdgcn_s_sleep(1); \
    if ((++_sp & 255u) == 0u) { if (xb_ld(&(bar)[XB_TMO])) break; if (_sp > XB_SPIN_CAP) { atomicAdd(&(bar)[XB_TMO], 1u); break; } } } } while (0)

struct XcdBarrier {
    unsigned* bar; unsigned x;
    volatile LAS unsigned* st;
};

__device__ __forceinline__ XcdBarrier xcd_barrier_post(unsigned* bar, volatile LAS unsigned* st) {
    XcdBarrier b; b.bar = bar; b.x = xb_xcc_id(); b.st = st;
    if (threadIdx.x == 0) (void)xb_add(&bar[XB_XCNT(b.x)], 1u);
    return b;
}
__device__ __forceinline__ void xcd_barrier_complete(unsigned* bar, unsigned x, unsigned& nloc, unsigned& nx) {
    const unsigned G = gridDim.x * gridDim.y * gridDim.z;
    unsigned sum, cnt, mine, sp = 0u;
    for (;;) {
        sum = 0u; cnt = 0u; mine = 0u;
#pragma unroll
        for (unsigned j = 0; j < 16; ++j) { const unsigned c = xb_ld(&bar[XB_XCNT(j)]); sum += c; cnt += (c > 0u) ? 1u : 0u; mine = (j == x) ? c : mine; }
        if (sum == G) break;
        __builtin_amdgcn_s_sleep(1);
        if ((++sp & 255u) == 0u) { if (xb_ld(&bar[XB_TMO])) break; if (sp > XB_SPIN_CAP) { atomicAdd(&bar[XB_TMO], 1u); break; } }
    }
    nloc = mine > 0u ? mine : 1u; nx = cnt > 0u ? cnt : 1u;
}

__device__ __forceinline__ void xcd_barrier(const XcdBarrier& b) {
    asm volatile("s_waitcnt vmcnt(0)" ::: "memory");
    __syncthreads();
    if (threadIdx.x == 0) {
        unsigned* bar = b.bar;
        __builtin_amdgcn_s_waitcnt(0);
        unsigned nloc = b.st[0], nx = b.st[1];
        if (nloc == 0u) { xcd_barrier_complete(bar, b.x, nloc, nx); b.st[0] = nloc; b.st[1] = nx; }
        const unsigned old = xb_add(&bar[XB_XSUB(b.x)], 1u);
        const unsigned gen = old / nloc;
        if (old + 1u == (gen + 1u) * nloc) {
            __builtin_amdgcn_fence(__ATOMIC_RELEASE, "agent");
            asm volatile("s_waitcnt vmcnt(0)" ::: "memory");
            const unsigned og = xb_add(&bar[XB_TOP], 1u);
            const unsigned tg = og / nx;
            if (og + 1u == (tg + 1u) * nx) xb_add(&bar[XB_TOPGEN], 1u);
            else XB_SPIN(xb_ld(&bar[XB_TOPGEN]) == tg, bar);
            __builtin_amdgcn_fence(__ATOMIC_ACQUIRE, "agent");
            xb_add(&bar[XB_XGEN(b.x)], 1u);
            asm volatile("s_waitcnt vmcnt(0)" ::: "memory");
        } else {
            XB_SPIN(xb_ld(&bar[XB_XGEN(b.x)]) == gen, bar);
            __builtin_amdgcn_fence(__ATOMIC_ACQUIRE, "agent");
            asm volatile("s_waitcnt vmcnt(0)" ::: "memory");
        }
    }
    __syncthreads();
}

__device__ __forceinline__ void grid_barrier(unsigned* bar, unsigned& gen) {
    asm volatile("s_waitcnt vmcnt(0)" ::: "memory");
    __syncthreads();
    if (threadIdx.x == 0) {
        gen += gridDim.x;
        __threadfence();
        __hip_atomic_fetch_add(bar, 1u, __ATOMIC_RELAXED, __HIP_MEMORY_SCOPE_AGENT);
        while (__hip_atomic_load(bar, __ATOMIC_RELAXED, __HIP_MEMORY_SCOPE_AGENT) < gen) __builtin_amdgcn_s_sleep(2);
        __threadfence();
    }
    __syncthreads();
}

template <int ACT> struct EpiStore {
    static constexpr bool PERM = true, AFTER_DRAIN = false;
    bf16_t* O; int ldc; size_t pnoff;
    __device__ __forceinline__ void operator()(const f32x4 (&acc)[2][2][4][2], const pg8::Unit& u, int wr, int wc, int fr, int fq) const {
        const int row0 = u.pm * 256 + wr * 64 + fr;
        bf16_t* base = O + (size_t)u.pn * pnoff + wc * 32 + 8 * fq;
#pragma unroll
        for (int ai = 0; ai < 2; ++ai)
#pragma unroll
            for (int m = 0; m < 4; ++m) {
                bf16_t* rowp = base + (size_t)(row0 + ai * 128 + m * 16) * ldc;
#pragma unroll
                for (int bj = 0; bj < 2; ++bj) {
                    f32x4 v0 = acc[ai][bj][m][0], v1 = acc[ai][bj][m][1];
                    if (ACT == 1) {
#pragma unroll
                        for (int e = 0; e < 4; ++e) { const float a = fmaxf(v0[e], 0.f), b = fmaxf(v1[e], 0.f); v0[e] = a * a; v1[e] = b * b; }
                    }
                    u32x4 w; w.x = pk2(v0[0], v0[1]); w.y = pk2(v0[2], v0[3]); w.z = pk2(v1[0], v1[1]); w.w = pk2(v1[2], v1[3]);
                    *(u32x4*)(rowp + bj * 128) = w;
                }
            }
    }
};
struct EpiResid {
    static constexpr bool PERM = true, AFTER_DRAIN = false;
    const float* xbase; const float* cbase; float* xout; float* cout; const float* gate;
    __device__ __forceinline__ void operator()(const f32x4 (&acc)[2][2][4][2], const pg8::Unit& u, int wr, int wc, int fr, int fq) const {
        const int R0 = u.pm * 256; const bool isx = R0 < MX;
        const float* base = isx ? xbase + (size_t)R0 * DM : cbase + (size_t)(R0 - MX) * DM;
        float* out = isx ? xout + (size_t)R0 * DM : cout + (size_t)(R0 - MX) * DM;
        const int bp = isx ? (R0 >> 12) : 8;
        const float* gtp = gate + (size_t)bp * 6144 + u.pn * 256;
        const unsigned cl = (unsigned)(wc * 32 + 8 * fq);
        const unsigned colg = (unsigned)(u.pn * 256) + cl;
        f32x4 gv[2][2];
#pragma unroll
        for (int bj = 0; bj < 2; ++bj)
#pragma unroll
            for (int n = 0; n < 2; ++n) gv[bj][n] = *(const f32x4*)(gtp + (cl + bj * 128 + n * 4));
#pragma unroll
        for (int ai = 0; ai < 2; ++ai)
#pragma unroll
            for (int mp = 0; mp < 2; ++mp) {
                f32x4 bs[2][2][2];
#pragma unroll
                for (int mm = 0; mm < 2; ++mm)
#pragma unroll
                    for (int bj = 0; bj < 2; ++bj)
#pragma unroll
                        for (int n = 0; n < 2; ++n)
                            bs[mm][bj][n] = *(const f32x4*)(base + ((unsigned)(ai * 128 + wr * 64 + (2 * mp + mm) * 16 + fr) * (unsigned)DM + colg + bj * 128 + n * 4));
#pragma unroll
                for (int mm = 0; mm < 2; ++mm) {
                    const int m = 2 * mp + mm;
                    const unsigned off = (unsigned)(ai * 128 + wr * 64 + m * 16 + fr) * (unsigned)DM + colg;
#pragma unroll
                    for (int bj = 0; bj < 2; ++bj)
#pragma unroll
                        for (int n = 0; n < 2; ++n)
                            *(f32x4*)(out + (off + bj * 128 + n * 4)) = bs[mm][bj][n] + gv[bj][n] * acc[ai][bj][m][n];
                }
                asm volatile("" ::: "memory");
            }
    }
};

struct EpiResid2 {
    static constexpr bool PERM = true, AFTER_DRAIN = false;
    const float* xbase; const float* cbase; float* xout; float* cout; const float* gate; bf16_t* A1; const float* gs; float* rs;
    __device__ __forceinline__ void operator()(const f32x4 (&acc)[2][2][4][2], const pg8::Unit& u, int wr, int wc, int fr, int fq) const {
        const int R0 = u.pm * 256; const bool isx = R0 < MX;
        const float* base = isx ? xbase + (size_t)R0 * DM : cbase + (size_t)(R0 - MX) * DM;
        float* out = isx ? xout + (size_t)R0 * DM : cout + (size_t)(R0 - MX) * DM;
        const int bp = isx ? (R0 >> 12) : 8;
        const float* gtp = gate + (size_t)bp * 6144 + u.pn * 256;
        const float* gsp = gs + (size_t)bp * DM + u.pn * 256;
        bf16_t* a1p = A1 + (size_t)R0 * DM;
        float* rsp = rs + R0;
        const unsigned cl = (unsigned)(wc * 32 + 8 * fq);
        const unsigned colg = (unsigned)(u.pn * 256) + cl;
        f32x4 gv[2][2];
#pragma unroll
        for (int bj = 0; bj < 2; ++bj)
#pragma unroll
            for (int n = 0; n < 2; ++n) gv[bj][n] = *(const f32x4*)(gtp + (cl + bj * 128 + n * 4));
#pragma unroll
        for (int ai = 0; ai < 2; ++ai)
#pragma unroll
            for (int mp = 0; mp < 2; ++mp) {
                f32x4 bs[2][2][2], gsv[2][2];
#pragma unroll
                for (int bj = 0; bj < 2; ++bj)
#pragma unroll
                    for (int n = 0; n < 2; ++n) gsv[bj][n] = *(const f32x4*)(gsp + (cl + bj * 128 + n * 4));
#pragma unroll
                for (int mm = 0; mm < 2; ++mm)
#pragma unroll
                    for (int bj = 0; bj < 2; ++bj)
#pragma unroll
                        for (int n = 0; n < 2; ++n)
                            bs[mm][bj][n] = *(const f32x4*)(base + ((unsigned)(ai * 128 + wr * 64 + (2 * mp + mm) * 16 + fr) * (unsigned)DM + colg + bj * 128 + n * 4));
#pragma unroll
                for (int mm = 0; mm < 2; ++mm) {
                    const int m = 2 * mp + mm;
                    const unsigned r = (unsigned)(ai * 128 + wr * 64 + m * 16 + fr);
                    const unsigned off = r * (unsigned)DM + colg;
                    float ssq = 0.f;
#pragma unroll
                    for (int bj = 0; bj < 2; ++bj) {
                        const f32x4 o0 = bs[mm][bj][0] + gv[bj][0] * acc[ai][bj][m][0], o1 = bs[mm][bj][1] + gv[bj][1] * acc[ai][bj][m][1];
                        *(f32x4*)(out + (off + bj * 128)) = o0; *(f32x4*)(out + (off + bj * 128 + 4)) = o1;
                        ssq += (o0[0] * o0[0] + o0[1] * o0[1]) + (o0[2] * o0[2] + o0[3] * o0[3]) + (o1[0] * o1[0] + o1[1] * o1[1]) + (o1[2] * o1[2] + o1[3] * o1[3]);
                        const f32x4 a0 = o0 * gsv[bj][0], a1 = o1 * gsv[bj][1];
                        *(u32x4*)(a1p + (off + bj * 128)) = (u32x4){pk2(a0[0], a0[1]), pk2(a0[2], a0[3]), pk2(a1[0], a1[1]), pk2(a1[2], a1[3])};
                    }
                    ssq += __shfl_xor(ssq, 16); ssq += __shfl_xor(ssq, 32);
                    if (fq == 0) atomicAdd(rsp + r, ssq);
                }
                asm volatile("" ::: "memory");
            }
    }
};
template <int ACT> struct EpiStoreN {
    static constexpr bool PERM = true, AFTER_DRAIN = false;
    bf16_t* O; int ldc; const float* rs; const float* shw; int shld;
    __device__ __forceinline__ void operator()(const f32x4 (&acc)[2][2][4][2], const pg8::Unit& u, int wr, int wc, int fr, int fq) const {
        const int R0 = u.pm * 256; const int bp = R0 < MX ? (R0 >> 12) : 8;
        const unsigned rl = (unsigned)(wr * 64 + fr);
        const unsigned colb = (unsigned)(u.pn * 256 + wc * 32 + 8 * fq);
        const float* svp = shw + (size_t)bp * shld;
        const float* rsp = rs + R0;
        bf16_t* base = O + (size_t)R0 * ldc;
        f32x4 sv[2][2]; float rstd[2][4];
#pragma unroll
        for (int bj = 0; bj < 2; ++bj)
#pragma unroll
            for (int n = 0; n < 2; ++n) sv[bj][n] = *(const f32x4*)(svp + (colb + bj * 128 + n * 4));
#pragma unroll
        for (int ai = 0; ai < 2; ++ai)
#pragma unroll
            for (int m = 0; m < 4; ++m) rstd[ai][m] = rsp[rl + ai * 128 + m * 16];
#pragma unroll
        for (int ai = 0; ai < 2; ++ai)
#pragma unroll
            for (int m = 0; m < 4; ++m) {
                const float rr = rsqrtf(rstd[ai][m] * (1.0f / 1024.0f) + 1e-6f);
                const unsigned off = (rl + ai * 128 + m * 16) * (unsigned)ldc + colb;
#pragma unroll
                for (int bj = 0; bj < 2; ++bj) {
                    f32x4 v0 = acc[ai][bj][m][0] * rr + sv[bj][0], v1 = acc[ai][bj][m][1] * rr + sv[bj][1];
                    if (ACT == 1) {
#pragma unroll
                        for (int e = 0; e < 4; ++e) { const float a = fmaxf(v0[e], 0.f), b = fmaxf(v1[e], 0.f); v0[e] = a * a; v1[e] = b * b; }
                    }
                    u32x4 w; w.x = pk2(v0[0], v0[1]); w.y = pk2(v0[2], v0[3]); w.z = pk2(v1[0], v1[1]); w.w = pk2(v1[2], v1[3]);
                    *(u32x4*)(base + (off + bj * 128)) = w;
                }
            }
    }
};

struct EpiSlab {
    static constexpr bool PERM = false, AFTER_DRAIN = false;
    float* slab;
    __device__ __forceinline__ void operator()(const f32x4 (&acc)[2][2][4][2], const pg8::Unit& u, int wr, int wc, int fr, int fq) const {
        float* base = slab + (size_t)u.pm * 256 * DM + u.pn * 256;
        const unsigned cl = (unsigned)(wc * 32 + 4 * fq);
#pragma unroll
        for (int ai = 0; ai < 2; ++ai)
#pragma unroll
            for (int m = 0; m < 4; ++m) {
                const unsigned off = (unsigned)(ai * 128 + wr * 64 + m * 16 + fr) * (unsigned)DM + cl;
#pragma unroll
                for (int bj = 0; bj < 2; ++bj)
#pragma unroll
                    for (int n = 0; n < 2; ++n) *(f32x4*)(base + (off + bj * 128 + n * 16)) = acc[ai][bj][m][n];
            }
    }
};
struct OneUnit {
    bool has; int pm, pn;
    __device__ bool next(int i, pg8::Unit& u) const { if (i != 0 || !has) return false; u.pm = pm; u.pn = pn; return true; }
    __device__ __forceinline__ void a_ready(const pg8::Unit&) const {}
    __device__ __forceinline__ void done(const pg8::Unit&) const {}
};

__device__ __forceinline__ void tr_tile(const float* src, int ldn, int k0, int n0, bf16_t* dst, int ldd, int drow0, int dcol0, int dcol1, LAS float* t, int tid) {
    {
        const int r = tid >> 3, cs = (tid & 7) * 8;
        const f32x4* s = (const f32x4*)(src + (size_t)(k0 + r) * ldn + n0 + cs);
        const f32x4 a = s[0], b = s[1];
        LAS float* tr = t + r * 65 + cs;
        tr[0] = a[0]; tr[1] = a[1]; tr[2] = a[2]; tr[3] = a[3]; tr[4] = b[0]; tr[5] = b[1]; tr[6] = b[2]; tr[7] = b[3];
    }
    __syncthreads();
    {
        const int n = tid >> 3, kc = (tid & 7) * 8;
        const LAS float* s = t + kc * 65 + n;
        u32x4 o; o.x = pk2(s[0], s[65]); o.y = pk2(s[2 * 65], s[3 * 65]); o.z = pk2(s[4 * 65], s[5 * 65]); o.w = pk2(s[6 * 65], s[7 * 65]);
        *(u32x4*)(dst + (size_t)(drow0 + n) * ldd + dcol0 + kc) = o;
        if (dcol1 >= 0) *(u32x4*)(dst + (size_t)(drow0 + n) * ldd + dcol1 + kc) = o;
    }
    __syncthreads();
}

__device__ __forceinline__ void prep_phase(const Params& p, LAS unsigned char* lds, int tid, int mask) {
    const int G = gridDim.x, bx = blockIdx.x;
    unsigned char* ws = p.ws;
    LAS float* lf = (LAS float*)lds;
    if (mask & 1) for (int u = bx; u < 192; u += G) {
        const int l = u / 96, r = u % 96, cbk = r >> 2, kq = r & 3;
        LAS float* sc = lf;
        LAS float* red = lf + 4096;
        for (int i = tid; i < 9 * 256; i += NTHREADS) {
            const int b = i >> 8, k = kq * 256 + (i & 255);
            const float v = b < 8 ? p.c[b * 1024 + k] : p.cctx[k];
            sc[i] = v / (1.0f + __expf(-v));
        }
        __syncthreads();
        const int lane = tid & 63, w = tid >> 6, col4 = lane * 4;
        const float* wp = p.w_ada + (size_t)l * 1024 * 6144 + (size_t)(kq * 256 + w * 32) * 6144 + cbk * 256 + col4;
        f32x4 acc[9];
#pragma unroll
        for (int b = 0; b < 9; ++b) acc[b] = (f32x4){0.f, 0.f, 0.f, 0.f};
        for (int h = 0; h < 2; ++h) {
            f32x4 wv[16];
#pragma unroll
            for (int j = 0; j < 16; ++j) wv[j] = *(const f32x4*)(wp + (size_t)(h * 16 + j) * 6144);
#pragma unroll
            for (int j = 0; j < 16; ++j) {
                const int kl = w * 32 + h * 16 + j;
#pragma unroll
                for (int b = 0; b < 9; ++b) acc[b] += wv[j] * sc[b * 256 + kl];
            }
        }
#pragma unroll
        for (int b = 0; b < 9; ++b) *(LAS f32x4*)(red + (w * 9 + b) * 256 + col4) = acc[b];
        __syncthreads();
        for (int i = tid; i < 9 * 256; i += NTHREADS) {
            const int b = i >> 8, jj = i & 255; float sum = 0.f;
#pragma unroll
            for (int g8 = 0; g8 < 8; ++g8) sum += red[(g8 * 9 + b) * 256 + jj];
            if (kq == 0) sum += p.b_ada[l * 6144 + cbk * 256 + jj];
            atomicAdd((float*)(ws + WS_MOD) + (size_t)(l * 9 + b) * 6144 + cbk * 256 + jj, sum);
        }
        __syncthreads();
    }
    if (mask & 2) for (int u = (bx + 1) % G; u < 1; u += G) {
        LAS unsigned short* tc = (LAS unsigned short*)lds; LAS unsigned short* tsn = tc + 4096;
        for (int i = tid; i < 256; i += NTHREADS) { float s, c; sincospif((float)i * (1.0f / 128.0f), &s, &c); tc[i] = f2bf(c * (1.0f / 128.0f)); tsn[i] = f2bf(s * (1.0f / 128.0f)); }
        __syncthreads();
        bf16_t* CTC = (bf16_t*)(ws + WS_CTC); bf16_t* STC = CTC + 256;
        for (int c = tid; c < 256 * 32; c += NTHREADS) {
            const int k = c >> 5, n0 = (c & 31) * 8;
            unsigned idx = ((unsigned)k * (unsigned)n0) & 255u;
            unsigned cw[4], sw[4];
#pragma unroll
            for (int e = 0; e < 4; ++e) {
                const unsigned i0 = idx; idx = (idx + k) & 255u; const unsigned i1 = idx; idx = (idx + k) & 255u;
                cw[e] = (unsigned)tc[i0] | ((unsigned)tc[i1] << 16); sw[e] = (unsigned)tsn[i0] | ((unsigned)tsn[i1] << 16);
            }
            *(u32x4*)(CTC + (size_t)k * 512 + n0) = (u32x4){cw[0], cw[1], cw[2], cw[3]};
            *(u32x4*)(STC + (size_t)k * 512 + n0) = (u32x4){sw[0], sw[1], sw[2], sw[3]};
        }
        __syncthreads();
    }
    {
        const int gt = bx * NTHREADS + tid;
        if (gt < 16384) {
            const int row = gt >> 7, kk = gt & 127, ro = row >> 6, k1 = row & 63, ri = kk >> 6, n1 = kk & 63;
            float sn, cs; sincospif((float)((n1 * k1) & 63) * (1.0f / 32.0f), &sn, &cs);
            const float v = (ro == ri) ? cs : (ro == 0 ? sn : -sn);
            ((bf16_t*)(ws + WS_FA))[gt] = f2bf(v * 0.125f);
        } else if (gt < 16384 + 8192) {
            const int q = gt - 16384, k2 = q >> 7, kk = q & 127, ro = kk >> 6, n2 = kk & 63;
            float sn, cs; sincospif((float)((n2 * k2) & 63) * (1.0f / 32.0f), &sn, &cs);
            ((bf16_t*)(ws + WS_FB))[q] = f2bf((ro == 0 ? cs : sn) * (1.0f / 64.0f));
        } else if (gt < 16384 + 8192 + 4096) {
            const int q = gt - 24576, n2 = q >> 6, k1 = q & 63;
            float sn, cs; sincospif((float)(n2 * k1) * (1.0f / 2048.0f), &sn, &cs);
            ((float*)(ws + WS_TW))[q * 2] = cs; ((float*)(ws + WS_TW))[q * 2 + 1] = sn;
        }
    }
    const int nfb = G < 64 ? G : 64;
    if (mask & 4) for (int u = bx - (G - nfb); u >= 0 && u < 128; u += nfb) {
        const int l = u >> 6, g = (u >> 4) & 3, k0 = (u & 15) * 64;
        LAS float* t = lf; LAS float* ctab = lf + 64 * 65; LAS float* stab = ctab + 64;
        {
            const int r = tid >> 3, cs = (tid & 7) * 8;
            const f32x4* s = (const f32x4*)(p.w_in + (size_t)l * 1024 * 1536 + (size_t)(k0 + r) * 1536 + 768 + g * 64 + cs);
            const f32x4 a = s[0], b = s[1];
            LAS float* tr = t + r * 65 + cs;
            tr[0] = a[0]; tr[1] = a[1]; tr[2] = a[2]; tr[3] = a[3]; tr[4] = b[0]; tr[5] = b[1]; tr[6] = b[2]; tr[7] = b[3];
        }
        if (tid < 64) { float s, c; sincospif((float)tid * (1.0f / 32.0f), &s, &c); ctab[tid] = c; stab[tid] = s; }
        __syncthreads();
        const int k = tid & 63, cg8 = tid >> 6;
        bf16_t* WIN = (bf16_t*)(ws + WS_WIN) + (size_t)l * NIN * 1024;
        for (int j = 0; j < 8; ++j) {
            const int cp = cg8 + 8 * j; float re = 0.f, im = 0.f;
#pragma unroll 8
            for (int c = 0; c < 64; ++c) { const float w = t[k * 65 + c]; const int idx = (c * cp) & 63; re += w * ctab[idx]; im -= w * stab[idx]; }
            WIN[(size_t)(768 + g * 128 + cp) * 1024 + k0 + k] = f2bf(re);
            WIN[(size_t)(768 + g * 128 + 64 + cp) * 1024 + k0 + k] = f2bf(im);
        }
        __syncthreads();
    }
    if (mask & 8) for (int u0 = bx * 4; u0 < 5248; u0 += G * 4) {
        const float* src[4]; bf16_t* dst[4]; int ldn[4], ldd[4];
#pragma unroll
        for (int j = 0; j < 4; ++j) {
            const int u = u0 + j, l = u / 2624; int r = u % 2624;
            if (r < 320) { const int kt = r / 20, jj = r % 20, nt = jj < 12 ? jj : jj + 4;
                src[j] = p.w_in + (size_t)l * 1024 * 1536 + (size_t)(kt * 64) * 1536 + nt * 64; ldn[j] = 1536;
                dst[j] = (bf16_t*)(ws + WS_WIN) + (size_t)l * NIN * 1024 + (size_t)(jj < 12 ? nt * 64 : nt * 64 + 256) * 1024 + kt * 64; ldd[j] = 1024; }
            else if (r < 576) { r -= 320; const int kt = r / 16, nt = r % 16;
                src[j] = p.w_out + (size_t)l * 1024 * 1024 + (size_t)(kt * 64) * 1024 + nt * 64; ldn[j] = 1024;
                dst[j] = (bf16_t*)(ws + WS_WOUT) + (size_t)l * 1024 * KOUT + (size_t)(nt * 64) * KOUT + kt * 64; ldd[j] = KOUT; }
            else if (r < 1600) { r -= 576; const int kt = r / 64, nt = r % 64;
                src[j] = p.w1 + (size_t)l * 1024 * 4096 + (size_t)(kt * 64) * 4096 + nt * 64; ldn[j] = 4096;
                dst[j] = (bf16_t*)(ws + WS_W1) + (size_t)l * 4096 * 1024 + (size_t)(nt * 64) * 1024 + kt * 64; ldd[j] = 1024; }
            else { r -= 1600; const int kt = r / 16, nt = r % 16;
                src[j] = p.w2 + (size_t)l * 4096 * 1024 + (size_t)(kt * 64) * 1024 + nt * 64; ldn[j] = 1024;
                dst[j] = (bf16_t*)(ws + WS_W2) + (size_t)l * 1024 * 4096 + (size_t)(nt * 64) * 4096 + kt * 64; ldd[j] = 4096; }
        }
        f32x4 a[4], b[4];
        {
            const int r = tid >> 3, cs = (tid & 7) * 8;
#pragma unroll
            for (int j = 0; j < 4; ++j) { const f32x4* sp = (const f32x4*)(src[j] + (size_t)r * ldn[j] + cs); a[j] = sp[0]; b[j] = sp[1]; }
#pragma unroll
            for (int j = 0; j < 4; ++j) {
                LAS float* tr = lf + j * (64 * 65) + r * 65 + cs;
                tr[0] = a[j][0]; tr[1] = a[j][1]; tr[2] = a[j][2]; tr[3] = a[j][3]; tr[4] = b[j][0]; tr[5] = b[j][1]; tr[6] = b[j][2]; tr[7] = b[j][3];
            }
        }
        __syncthreads();
        {
            const int n = tid >> 3, kc = (tid & 7) * 8;
#pragma unroll
            for (int j = 0; j < 4; ++j) {
                const LAS float* sp = lf + j * (64 * 65) + kc * 65 + n;
                u32x4 o; o.x = pk2(sp[0], sp[65]); o.y = pk2(sp[2 * 65], sp[3 * 65]); o.z = pk2(sp[4 * 65], sp[5 * 65]); o.w = pk2(sp[6 * 65], sp[7 * 65]);
                *(u32x4*)(dst[j] + (size_t)n * ldd[j] + kc) = o;
            }
        }
        __syncthreads();
    }
    {
        const int gt = bx * NTHREADS + tid, GT = G * NTHREADS;
        for (int i = gt; i < 3 * MT; i += GT) ((float*)(ws + WS_RS))[i] = 0.f;
        bf16_t* WSB = (bf16_t*)(ws + WS_WSB);
        for (int i = gt; i < 2 * 4 * 128 * 128 / 8; i += GT) {
            const f32x4 a = *(const f32x4*)(p.wsp + (size_t)i * 8), b = *(const f32x4*)(p.wsp + (size_t)i * 8 + 4);
            *(u32x4*)(WSB + (size_t)i * 8) = (u32x4){pk2(a[0], a[1]), pk2(a[2], a[3]), pk2(b[0], b[1]), pk2(b[2], b[3])};
        }
        if (gt < 1024) {
            const int pos = gt >> 4, i = gt & 15;
            const float inv = exp2f(-(float)i * (13.287712379549449f / 16.0f));
            const float ang = (float)pos * inv; float s, c; sincospif(ang * 0.3183098861837907f, &s, &c);
            ((float*)(ws + WS_ROPE))[gt * 2] = c; ((float*)(ws + WS_ROPE))[gt * 2 + 1] = s;
        }
    }
}

__device__ __forceinline__ void norm_phase(const float* xs, const float* cs, const float* g, const float* modl, int which, bf16_t* A1, int nrows, int tid) {
    const int lane = tid & 63, wave = tid >> 6;
    f32x4 gvv[4];
#pragma unroll
    for (int j = 0; j < 4; ++j) gvv[j] = *(const f32x4*)(g + 4 * lane + 256 * j);
    for (int row = blockIdx.x * 8 + wave; row < nrows; row += gridDim.x * 8) {
        const float* src = row < MX ? xs + (size_t)row * DM : cs + (size_t)(row - MX) * DM;
        const int bp = row < MX ? (row >> 12) : 8;
        const float* sh = modl + (size_t)bp * 6144 + which * 3 * 1024; const float* scl = sh + 1024;
        f32x4 v[4]; float ss = 0.f;
#pragma unroll
        for (int j = 0; j < 4; ++j) { v[j] = *(const f32x4*)(src + 4 * lane + 256 * j); ss += (v[j][0] * v[j][0] + v[j][1] * v[j][1]) + (v[j][2] * v[j][2] + v[j][3] * v[j][3]); }
        const float r = rsqrtf(wave_sum(ss) * (1.0f / 1024.0f) + 1e-6f);
#pragma unroll
        for (int j = 0; j < 4; ++j) {
            const f32x4 s1 = *(const f32x4*)(scl + 4 * lane + 256 * j), s0 = *(const f32x4*)(sh + 4 * lane + 256 * j);
            f32x4 y = v[j] * r * gvv[j]; y = y * (s1 + 1.0f) + s0;
            *(u32x2*)(A1 + (size_t)row * DM + 4 * lane + 256 * j) = (u32x2){pk2(y[0], y[1]), pk2(y[2], y[3])};
        }
    }
}

__device__ __forceinline__ void aux_phase(const Params& p, LAS unsigned char* lds, int tid) {
    unsigned char* ws = p.ws;
    const float* MOD = (const float*)(ws + WS_MOD);
    {
        const int gt = blockIdx.x * NTHREADS + tid, GT = gridDim.x * NTHREADS;
        float* GS = (float*)(ws + WS_GS);
        for (int i = gt; i < 2 * 2 * 9 * 1024; i += GT) {
            const int k = i & 1023, bp = (i >> 10) % 9, lw = i / 9216, l = lw >> 1, w = lw & 1;
            const float g = (w == 0 ? p.g1 : p.g2)[l * 1024 + k];
            GS[i] = g * (1.0f + MOD[(size_t)(l * 9 + bp) * 6144 + (w * 3 + 1) * 1024 + k]);
        }
    }
    LAS float* sh = (LAS float*)lds;
    for (int u = blockIdx.x; u < 156; u += gridDim.x) {
        int l, n0, which, N; const bf16_t* W; float* dst;
        if (u < 128) { l = u >> 6; n0 = (u & 63) * 64; which = 1; N = 4096; W = (const bf16_t*)(ws + WS_W1) + (size_t)l * 4096 * 1024; dst = (float*)(ws + WS_SHW) + (size_t)l * 9 * 4096; }
        else { l = 1; n0 = (u - 128) * 64; which = 0; N = NIN; W = (const bf16_t*)(ws + WS_WIN) + (size_t)NIN * 1024; dst = (float*)(ws + WS_SHW) + 131072; }
        for (int i = tid; i < 9 * 1024; i += NTHREADS) sh[(i >> 10) * 1032 + (i & 1023) + ((i & 1023) >> 7)] = MOD[(size_t)(l * 9 + (i >> 10)) * 6144 + which * 3 * 1024 + (i & 1023)];
        __syncthreads();
        const int col = tid >> 3, kg = tid & 7;
        float acc[9];
#pragma unroll
        for (int b = 0; b < 9; ++b) acc[b] = 0.f;
        const bf16_t* wp = W + (size_t)(n0 + col) * 1024 + kg * 128;
#pragma unroll 4
        for (int c = 0; c < 16; ++c) {
            const u32x4 v = *(const u32x4*)(wp + c * 8);
            float y[8]; unpack8(v, y);
#pragma unroll
            for (int e = 0; e < 8; ++e)
#pragma unroll
                for (int b = 0; b < 9; ++b) acc[b] += sh[b * 1032 + kg * 129 + c * 8 + e] * y[e];
        }
#pragma unroll
        for (int b = 0; b < 9; ++b) { float a = acc[b]; a += __shfl_xor(a, 1); a += __shfl_xor(a, 2); a += __shfl_xor(a, 4); if (kg == 0) dst[(size_t)b * N + n0 + col] = a; }
        __syncthreads();
    }
}

__device__ __forceinline__ void ctx_finish_phase(const Params& p, int tid, int which) {
    unsigned char* ws = p.ws;
    const int lane = tid & 63, wave = tid >> 6;
    float* XC = (float*)(ws + WS_XC); const float* SL = (const float*)(ws + WS_SLAB);
    const float* BASE = which == 0 ? p.ctx : XC;
    const float* gate = (const float*)(ws + WS_MOD) + (size_t)8 * 6144 + (which == 0 ? 2 : 5) * 1024;
    const float* gs = (const float*)(ws + WS_GS) + (size_t)((which == 0 ? 1 : 2) * 9 + 8) * 1024;
    bf16_t* A1 = (bf16_t*)(ws + WS_A1); float* RS1 = (float*)(ws + WS_RS) + (which == 0 ? 0 : MT);
    for (int row = blockIdx.x * 8 + wave; row < MC; row += gridDim.x * 8) {
        float ss = 0.f;
#pragma unroll
        for (int j = 0; j < 4; ++j) {
            const int col = 4 * lane + 256 * j; const size_t o = (size_t)row * DM + col;
            f32x4 a = *(const f32x4*)(SL + o);
#pragma unroll
            for (int ks = 1; ks < 4; ++ks) a += *(const f32x4*)(SL + (size_t)ks * MC * DM + o);
            const f32x4 x = *(const f32x4*)(BASE + o) + *(const f32x4*)(gate + col) * a;
            *(f32x4*)(XC + o) = x;
            ss += (x[0] * x[0] + x[1] * x[1]) + (x[2] * x[2] + x[3] * x[3]);
            const f32x4 y = x * *(const f32x4*)(gs + col);
            *(u32x2*)(A1 + (size_t)(MX + row) * DM + col) = (u32x2){pk2(y[0], y[1]), pk2(y[2], y[3])};
        }
        ss = wave_sum(ss);
        if (lane == 0) RS1[MX + row] = ss;
    }
}

__device__ __forceinline__ int perm16(int row) { const int q = (row >> 2) & 3; const int q2 = (q == 1) ? 2 : (q == 2 ? 1 : q); return (row & ~15) | (q2 << 2) | (row & 3); }
template <bool PERMK, class F> __device__ __forceinline__ void post_transpose(const bf16_t* px, int c0, LAS unsigned short* Lt, int tid, F&& destrow) {
    u32x4 v[4];
#pragma unroll
    for (int j = 0; j < 4; ++j) { const int c = tid + j * NTHREADS; v[j] = *(const u32x4*)(px + (size_t)(c >> 4) * NIN + c0 + (c & 15) * 8); }
#pragma unroll
    for (int j = 0; j < 4; ++j) {
        const int c = tid + j * NTHREADS, row = c >> 4, ch = c & 15;
        const int pr = (PERMK ? perm16(row) : row) ^ (ch << 3);
        LAS unsigned short* d = Lt + (ch * 8) * 136 + pr;
        d[0] = (unsigned short)(v[j].x & 0xffff); d[136] = (unsigned short)(v[j].x >> 16); d[2 * 136] = (unsigned short)(v[j].y & 0xffff); d[3 * 136] = (unsigned short)(v[j].y >> 16);
        d[4 * 136] = (unsigned short)(v[j].z & 0xffff); d[5 * 136] = (unsigned short)(v[j].z >> 16); d[6 * 136] = (unsigned short)(v[j].w & 0xffff); d[7 * 136] = (unsigned short)(v[j].w >> 16);
    }
    __syncthreads();
#pragma unroll
    for (int j = 0; j < 4; ++j) {
        const int c = tid + j * NTHREADS, col = c >> 4, ch = c & 15;
        const u32x4 w = *(const LAS u32x4*)(Lt + col * 136 + ((ch * 8) ^ (((col >> 3) & 15) << 3)));
        *(u32x4*)(destrow(col) + ch * 8) = w;
    }
    __syncthreads();
}

__device__ __forceinline__ void post_phase(const Params& p, int l, LAS unsigned char* lds, int tid) {
    unsigned char* ws = p.ws;
    const bf16_t* PX = (const bf16_t*)(ws + WS_PX);
    bf16_t* QS = (bf16_t*)(ws + WS_QS); bf16_t* KS = (bf16_t*)(ws + WS_KS); bf16_t* VT = (bf16_t*)(ws + WS_VT);
    bf16_t* ZT = (bf16_t*)(ws + WS_ZT); bf16_t* ZTC = (bf16_t*)(ws + WS_ZTC); bf16_t* MIX = (bf16_t*)(ws + WS_MIX);
    LAS unsigned short* Lt = (LAS unsigned short*)lds;
    LAS float* ropeL = (LAS float*)(lds + 131072);
    for (int i = tid; i < 2048; i += NTHREADS) ropeL[i] = ((const float*)(ws + WS_ROPE))[i];
    __syncthreads();
    const int lane = tid & 63, wave = tid >> 6;
    unsigned* qctr = (unsigned*)(ws + 32768) + 64 * l;
    volatile LAS unsigned* qnext = (volatile LAS unsigned*)(lds + 139328);
    for (int u = blockIdx.x; u < 272 * 3; ) {
        const int part = u / 272, ci = u % 272;
        const bool isx = ci < 256;
        const int R0 = ci * 128;
        const int b = isx ? (ci >> 5) : ((ci - 256) >> 1);
        const int n0 = isx ? (ci & 31) * 128 : ((ci - 256) & 1) * 128;
        const int t0 = isx ? 256 + n0 : n0;
        const bf16_t* px = PX + (size_t)R0 * NIN;
        if (part == 0) {
            for (int it = 0; it < 5; ++it) {
                u32x4 v[4];
#pragma unroll
                for (int j = 0; j < 4; ++j) { const int task = (it * 4 + j) * NTHREADS + tid; const int tok = task / 80, rem = task - tok * 80; v[j] = *(const u32x4*)(px + (size_t)tok * NIN + rem * 8); }
#pragma unroll
                for (int j = 0; j < 4; ++j) {
                    const int task = (it * 4 + j) * NTHREADS + tid; const int tok = task / 80, rem = task - tok * 80, hh = rem >> 3, ch = rem & 7;
                    float y[8]; unpack8(v[j], y);
                    float ss = 0.f;
#pragma unroll
                    for (int e = 0; e < 8; ++e) ss += y[e] * y[e];
                    ss = sum8(ss);
                    const float r = rsqrtf(ss * (1.0f / 64.0f) + 1e-6f);
                    const float* gg = (hh < 8 ? p.qg : p.kg) + l * 64 + ch * 8;
                    const f32x4 g0 = *(const f32x4*)gg, g1 = *(const f32x4*)(gg + 4);
#pragma unroll
                    for (int e = 0; e < 4; ++e) { y[e] *= r * g0[e]; y[4 + e] *= r * g1[e]; }
                    float o[8];
                    if (isx) {
                        const int n = n0 + tok, pos = (ch < 4) ? (n >> 6) : (n & 63);
                        const LAS f32x4* rp = (const LAS f32x4*)(ropeL + (pos * 16 + (ch & 1) * 8) * 2);
                        const f32x4 t0v = rp[0], t1v = rp[1], t2v = rp[2], t3v = rp[3];
                        const float cs[8] = {t0v[0], t0v[2], t1v[0], t1v[2], t2v[0], t2v[2], t3v[0], t3v[2]};
                        const float sn[8] = {t0v[1], t0v[3], t1v[1], t1v[3], t2v[1], t2v[3], t3v[1], t3v[3]};
                        const bool second = (ch & 2) != 0;
#pragma unroll
                        for (int e = 0; e < 8; ++e) { const float pv = dpp_xor2(y[e]); o[e] = second ? (pv * sn[e] + y[e] * cs[e]) : (y[e] * cs[e] - pv * sn[e]); }
                    } else {
#pragma unroll
                        for (int e = 0; e < 8; ++e) o[e] = y[e];
                    }
                    bf16_t* d;
                    if (hh < 8) {
#pragma unroll
                        for (int e = 0; e < 8; ++e) o[e] *= QSCALE;
                        d = QS + ((size_t)(b * 8 + hh) * TKV + t0 + tok) * 64 + ch * 8;
                    } else d = KS + ((size_t)(b * 2 + (hh - 8)) * TKV + t0 + tok) * 64 + ch * 8;
                    *(u32x4*)d = (u32x4){pk2(o[0], o[1]), pk2(o[2], o[3]), pk2(o[4], o[5]), pk2(o[6], o[7])};
                }
            }
            post_transpose<true>(px, 640, Lt, tid, [&](int col) { return VT + ((size_t)(b * 2 + (col >> 6)) * 64 + (col & 63)) * TKV + t0; });
        } else if (part == 1) {
            for (int g = 0; g < 4; ++g) {
                if (isx) post_transpose<false>(px, 768 + g * 128, Lt, tid, [&](int col) { return ZT + ((size_t)((col >> 6) * 2048 + b * 256 + g * 64 + (col & 63))) * 4096 + n0; });
                else     post_transpose<false>(px, 768 + g * 128, Lt, tid, [&](int col) { return ZTC + ((size_t)(b * 256 + g * 64 + (col & 63))) * 512 + (col >> 6) * 256 + n0; });
            }
        } else {
            for (int it = 0; it < 2; ++it) {
                u32x4 v[4];
#pragma unroll
                for (int j = 0; j < 4; ++j) { const int task = (it * 4 + j) * NTHREADS + tid; v[j] = *(const u32x4*)(px + (size_t)(task >> 5) * NIN + 1536 + (task & 31) * 8); }
#pragma unroll
                for (int j = 0; j < 4; ++j) {
                    const int task = (it * 4 + j) * NTHREADS + tid; const int tok = task >> 5, c8 = task & 31;
                    float y[8]; unpack8(v[j], y);
                    float ss = 0.f;
#pragma unroll
                    for (int e = 0; e < 8; ++e) { y[e] = gelu_t(y[e]); ss += y[e] * y[e]; }
                    ss = sum8(ss);
                    const float r = rsqrtf(ss * (1.0f / 64.0f) + 1e-6f);
                    const float* gg = p.vg + l * 256 + c8 * 8;
                    const f32x4 g0 = *(const f32x4*)gg, g1 = *(const f32x4*)(gg + 4);
                    LAS unsigned short* d = Lt + (c8 * 8) * 136 + (tok ^ ((c8 & 15) << 3));
#pragma unroll
                    for (int e = 0; e < 4; ++e) { d[e * 136] = f2bf(y[e] * r * g0[e]); d[(4 + e) * 136] = f2bf(y[4 + e] * r * g1[e]); }
                }
            }
            __syncthreads();
            {
                const int h = wave >> 1, db = wave & 1, r32 = lane & 31, hi = lane >> 5;
                const int col = h * 64 + db * 32 + r32, swz = ((col >> 3) & 15) << 3;
                bf16x8 bfr[8];
#pragma unroll
                for (int s = 0; s < 8; ++s) bfr[s] = *(const LAS bf16x8*)(Lt + col * 136 + ((16 * s + 8 * hi) ^ swz));
                const bf16_t* wsb = (const bf16_t*)(ws + WS_WSB) + (size_t)(l * 4 + h) * 128 * 128;
                const float* bs = p.bsp + (size_t)(l * 4 + h) * 128;
                for (int pb = 0; pb < 4; ++pb) {
                    unsigned short uu[16];
#pragma unroll
                    for (int e = 0; e < 16; ++e) uu[e] = px[(size_t)(pb * 32 + (e & 3) + 8 * (e >> 2) + 4 * hi) * NIN + 1280 + col];
                    f32x16 acc;
#pragma unroll
                    for (int e = 0; e < 16; ++e) acc[e] = 0.f;
#pragma unroll
                    for (int s = 0; s < 8; ++s) {
                        const bf16x8 a = *(const bf16x8*)(wsb + (size_t)(pb * 32 + r32) * 128 + 16 * s + 8 * hi);
                        acc = __builtin_amdgcn_mfma_f32_32x32x16_bf16(a, bfr[s], acc, 0, 0, 0);
                    }
#pragma unroll
                    for (int e = 0; e < 16; ++e) {
                        const int pp = pb * 32 + (e & 3) + 8 * (e >> 2) + 4 * hi;
                        MIX[(size_t)(R0 + pp) * KOUT + 768 + col] = f2bf(gelu_t(bf2f(uu[e])) * (acc[e] + bs[pp]));
                    }
                }
            }
            __syncthreads();
        }
        if (tid == 0) *qnext = gridDim.x + __hip_atomic_fetch_add(qctr, 1u, __ATOMIC_RELAXED, __HIP_MEMORY_SCOPE_AGENT);
        __syncthreads();
        u = (int)*qnext;
        __syncthreads();
    }
}

__device__ __forceinline__ void fft_phase(const Params& p, LAS unsigned char* lds, int tid) {
    unsigned char* ws = p.ws;
    const bf16_t* ZT = (const bf16_t*)(ws + WS_ZT); bf16_t* MIX = (bf16_t*)(ws + WS_MIX);
    const bf16_t* FA = (const bf16_t*)(ws + WS_FA); const bf16_t* FB = (const bf16_t*)(ws + WS_FB); const float* TW = (const float*)(ws + WS_TW);
    LAS unsigned short* Z = (LAS unsigned short*)lds;
    const int lane = tid & 63, w = tid >> 6, r32 = lane & 31, hi = lane >> 5;
    for (int u = blockIdx.x; u < 256; u += gridDim.x) {
        const int b = u >> 5, g = (u >> 3) & 3, cb = u & 7;
        {
            u32x4 v[16];
#pragma unroll
            for (int j = 0; j < 16; ++j) v[j] = *(const u32x4*)(ZT + ((size_t)((j >> 3) * 2048 + b * 256 + g * 64 + cb * 8 + (j & 7))) * 4096 + tid * 8);
#pragma unroll
            for (int j = 0; j < 16; ++j) *(LAS u32x4*)(Z + j * 4096 + tid * 8) = v[j];
        }
        __syncthreads();
        LAS unsigned short* Zr = Z + w * 4096; LAS unsigned short* Zi = Z + (8 + w) * 4096;
        for (int nh = 0; nh < 2; ++nh) {
            const int n2 = nh * 32 + r32;
            int two = (n2 * 64 + 4 * hi) * 2; asm volatile("" : "+v"(two));
            const GAS float* twp = (const GAS float*)TW + two;
            f32x4 tw0[2][4], tw1[2][4];
#pragma unroll
            for (int rg = 0; rg < 4; ++rg) { tw0[0][rg] = *(const GAS f32x4*)(twp + (8 * rg) * 2); tw1[0][rg] = *(const GAS f32x4*)(twp + (8 * rg) * 2 + 4); }
            bf16x8 bfA[8];
#pragma unroll
            for (int s = 0; s < 8; ++s) {
                const LAS unsigned short* q = Z + ((s >> 2) * 8 + w) * 4096 + (16 * (s & 3) + 8 * hi) * 64 + n2;
                u32x4 t;
                t.x = (unsigned)q[0] | ((unsigned)q[64] << 16); t.y = (unsigned)q[128] | ((unsigned)q[192] << 16);
                t.z = (unsigned)q[256] | ((unsigned)q[320] << 16); t.w = (unsigned)q[384] | ((unsigned)q[448] << 16);
                bfA[s] = __builtin_bit_cast(bf16x8, t);
            }
            f32x16 acc[4];
            int fao = r32 * 128 + 8 * hi; asm volatile("" : "+v"(fao));
            const GAS bf16_t* fap = (const GAS bf16_t*)FA + fao;
#pragma unroll
            for (int mt = 0; mt < 4; ++mt) {
#pragma unroll
                for (int e = 0; e < 16; ++e) acc[mt][e] = 0.f;
#pragma unroll
                for (int s = 0; s < 8; ++s) {
                    const bf16x8 a = *(const GAS bf16x8*)(fap + mt * 32 * 128 + 16 * s);
                    acc[mt] = __builtin_amdgcn_mfma_f32_32x32x16_bf16(a, bfA[s], acc[mt], 0, 0, 0);
                }
                asm volatile("" ::: "memory");
            }
#pragma unroll
            for (int rg = 0; rg < 4; ++rg) { tw0[1][rg] = *(const GAS f32x4*)(twp + (32 + 8 * rg) * 2); tw1[1][rg] = *(const GAS f32x4*)(twp + (32 + 8 * rg) * 2 + 4); }
#pragma unroll
            for (int mt = 0; mt < 2; ++mt)
#pragma unroll
                for (int rg = 0; rg < 4; ++rg) {
                    const int k1b = 32 * mt + 8 * rg + 4 * hi;
                    const f32x4 t0 = tw0[mt][rg], t1 = tw1[mt][rg];
                    const float ct[4] = {t0[0], t0[2], t1[0], t1[2]}, st[4] = {t0[1], t0[3], t1[1], t1[3]};
#pragma unroll
                    for (int e = 0; e < 4; ++e) {
                        const int k1 = k1b + e; const float tr = acc[mt][4 * rg + e], ti = acc[mt + 2][4 * rg + e];
                        const int pos = k1 * 64 + ((((n2 >> 3) ^ (k1 & 3)) << 3) | (n2 & 7));
                        Zr[pos] = f2bf(tr * ct[e] + ti * st[e]); Zi[pos] = f2bf(ti * ct[e] - tr * st[e]);
                    }
                }
        }
        __syncthreads();
        f32x16 y[2][2];
#pragma unroll
        for (int nt = 0; nt < 2; ++nt) {
            const int k1 = nt * 32 + r32;
            bf16x8 bfB[8];
#pragma unroll
            for (int s = 0; s < 8; ++s) bfB[s] = *(const LAS bf16x8*)(Z + ((s >> 2) * 8 + w) * 4096 + k1 * 64 + (((2 * (s & 3) + hi) ^ (k1 & 3)) << 3));
            int fbo = r32 * 128 + 8 * hi; asm volatile("" : "+v"(fbo));
            const GAS bf16_t* fbp = (const GAS bf16_t*)FB + fbo;
#pragma unroll
            for (int mt = 0; mt < 2; ++mt) {
#pragma unroll
                for (int e = 0; e < 16; ++e) y[mt][nt][e] = 0.f;
#pragma unroll
                for (int s = 0; s < 8; ++s) {
                    const bf16x8 a = *(const GAS bf16x8*)(fbp + mt * 32 * 128 + 16 * s);
                    y[mt][nt] = __builtin_amdgcn_mfma_f32_32x32x16_bf16(a, bfB[s], y[mt][nt], 0, 0, 0);
                }
                asm volatile("" ::: "memory");
            }
        }
        __syncthreads();
#pragma unroll
        for (int mt = 0; mt < 2; ++mt)
#pragma unroll
            for (int nt = 0; nt < 2; ++nt)
#pragma unroll
                for (int e = 0; e < 16; ++e) {
                    const int k2 = 32 * mt + (e & 3) + 8 * (e >> 2) + 4 * hi, k = nt * 32 + r32 + 64 * k2;
                    Z[k * 8 + w] = f2bf(y[mt][nt][e]);
                }
        __syncthreads();
#pragma unroll
        for (int j = 0; j < 8; ++j) {
            const int k = j * NTHREADS + tid;
            const u32x4 v = *(const LAS u32x4*)(Z + k * 8);
            bf16_t* d = MIX + (size_t)(b * SEQ + k) * KOUT + 512 + g * 64 + cb * 8;
            *(u32x4*)d = v;
        }
        asm volatile("s_waitcnt lgkmcnt(0)" ::: "memory"); __builtin_amdgcn_s_barrier(); asm volatile("" ::: "memory");
    }
}

__device__ __forceinline__ void attn_unit(const bf16_t* Q, const bf16_t* K, const bf16_t* Vt, int ntiles, int nrows, bf16_t* O, float negM, LAS unsigned char* lds, int tid) {
    const int lane = tid & 63, w = tid >> 6, r32 = lane & 31, hi = lane >> 5;
    const int row0 = w * 64 + r32, row1 = row0 + 32;
    bf16x8 qa[4], qb[4];
    {
        const bf16_t* qp0 = Q + (size_t)min(row0, nrows - 1) * 64 + hi * 8;
        const bf16_t* qp1 = Q + (size_t)min(row1, nrows - 1) * 64 + hi * 8;
#pragma unroll
        for (int s = 0; s < 4; ++s) { qa[s] = *(const bf16x8*)(qp0 + 16 * s); qb[s] = *(const bf16x8*)(qp1 + 16 * s); }
    }
    LAS unsigned char* qlds = lds + 40960 + w * 4096 + lane * 16;
#pragma unroll
    for (int s = 0; s < 4; ++s) *(LAS bf16x8*)(qlds + s * 1024) = qb[s];
    f32x16 oa0, oa1, ob0, ob1;
#pragma unroll
    for (int e = 0; e < 16; ++e) { oa0[e] = 0.f; oa1[e] = 0.f; ob0[e] = 0.f; ob1[e] = 0.f; }
    float lsa = 0.f, lsb = 0.f;
    const int srow = tid >> 3, sch = tid & 7;
    const bf16_t* kg = K + srow * 64 + sch * 8;
    const bf16_t* vg = Vt + (size_t)srow * TKV + sch * 8;
    const int soff = srow * 144 + sch * 16;
    u32x4 kr = *(const u32x4*)kg, vr = *(const u32x4*)vg;
    *(LAS u32x4*)(lds + soff) = kr; *(LAS u32x4*)(lds + 9216 + soff) = vr;
    __syncthreads();
    const int foff = r32 * 144 + hi * 16;
#define ATT_SCORES(QF, PF, LS) do { \
        f32x16 p0, p1; \
        _Pragma("unroll") for (int e = 0; e < 16; ++e) { p0[e] = negM; p1[e] = negM; } \
        _Pragma("unroll") for (int s = 0; s < 4; ++s) { p0 = __builtin_amdgcn_mfma_f32_32x32x16_bf16(kf0[s], QF[s], p0, 0, 0, 0); p1 = __builtin_amdgcn_mfma_f32_32x32x16_bf16(kf1[s], QF[s], p1, 0, 0, 0); } \
        float ls = 0.f; \
        _Pragma("unroll") for (int e = 0; e < 16; ++e) { p0[e] = __builtin_amdgcn_exp2f(p0[e]); p1[e] = __builtin_amdgcn_exp2f(p1[e]); ls += p0[e] + p1[e]; } \
        LS += ls; \
        _Pragma("unroll") for (int hf = 0; hf < 2; ++hf) { u32x4 a, c; \
            a.x = pk2(p0[8 * hf + 0], p0[8 * hf + 1]); a.y = pk2(p0[8 * hf + 2], p0[8 * hf + 3]); a.z = pk2(p0[8 * hf + 4], p0[8 * hf + 5]); a.w = pk2(p0[8 * hf + 6], p0[8 * hf + 7]); \
            c.x = pk2(p1[8 * hf + 0], p1[8 * hf + 1]); c.y = pk2(p1[8 * hf + 2], p1[8 * hf + 3]); c.z = pk2(p1[8 * hf + 4], p1[8 * hf + 5]); c.w = pk2(p1[8 * hf + 6], p1[8 * hf + 7]); \
            PF[hf] = __builtin_bit_cast(bf16x8, a); PF[2 + hf] = __builtin_bit_cast(bf16x8, c); } \
    } while (0)
    asm volatile("" : "+s"(ntiles));
#pragma clang loop unroll(disable)
    for (int t = 0; t < ntiles; ++t) {
        const int cur = t & 1;
        const bool more = (t + 1 < ntiles);
        if (more) { kr = *(const u32x4*)(kg + (size_t)(t + 1) * 4096); vr = *(const u32x4*)(vg + (size_t)(t + 1) * 64); }
        const LAS unsigned char* kb = lds + cur * 18432 + foff;
        const LAS unsigned char* vb = kb + 9216;
        bf16x8 kf0[4], kf1[4];
#pragma unroll
        for (int s = 0; s < 4; ++s) { kf0[s] = *(const LAS bf16x8*)(kb + s * 32); kf1[s] = *(const LAS bf16x8*)(kb + 32 * 144 + s * 32); }
        bf16x8 pa[4], pb[4];
        ATT_SCORES(qa, pa, lsa);
        bf16x8 qc[4];
#pragma unroll
        for (int s = 0; s < 4; ++s) qc[s] = *(const LAS bf16x8*)(qlds + s * 1024);
        ATT_SCORES(qc, pb, lsb);
#pragma unroll
        for (int s = 0; s < 4; ++s) {
            const bf16x8 v0 = *(const LAS bf16x8*)(vb + s * 32), v1 = *(const LAS bf16x8*)(vb + 32 * 144 + s * 32);
            oa0 = __builtin_amdgcn_mfma_f32_32x32x16_bf16(v0, pa[s], oa0, 0, 0, 0);
            oa1 = __builtin_amdgcn_mfma_f32_32x32x16_bf16(v1, pa[s], oa1, 0, 0, 0);
            ob0 = __builtin_amdgcn_mfma_f32_32x32x16_bf16(v0, pb[s], ob0, 0, 0, 0);
            ob1 = __builtin_amdgcn_mfma_f32_32x32x16_bf16(v1, pb[s], ob1, 0, 0, 0);
        }
        if (more) { *(LAS u32x4*)(lds + (cur ^ 1) * 18432 + soff) = kr; *(LAS u32x4*)(lds + (cur ^ 1) * 18432 + 9216 + soff) = vr; }
        __syncthreads();
    }
#undef ATT_SCORES
#define ATT_STORE(O0, O1, LS, ROW) do { if ((ROW) < nrows) { float l = LS; l += __shfl_xor(l, 32); const float inv = 1.0f / l; \
        bf16_t* op = O + (size_t)(ROW) * KOUT + 4 * hi; \
        _Pragma("unroll") for (int rg = 0; rg < 4; ++rg) { \
            *(u32x2*)(op + 8 * rg) = (u32x2){pk2(O0[4 * rg] * inv, O0[4 * rg + 1] * inv), pk2(O0[4 * rg + 2] * inv, O0[4 * rg + 3] * inv)}; \
            *(u32x2*)(op + 32 + 8 * rg) = (u32x2){pk2(O1[4 * rg] * inv, O1[4 * rg + 1] * inv), pk2(O1[4 * rg + 2] * inv, O1[4 * rg + 3] * inv)}; } } } while (0)
    ATT_STORE(oa0, oa1, lsa, row0);
    ATT_STORE(ob0, ob1, lsb, row1);
#undef ATT_STORE
}

__device__ __forceinline__ void attn_phase(const Params& p, int l, LAS unsigned char* lds, int tid) {
    unsigned char* ws = p.ws;
    const bf16_t* QS = (const bf16_t*)(ws + WS_QS); const bf16_t* KS = (const bf16_t*)(ws + WS_KS); const bf16_t* VT = (const bf16_t*)(ws + WS_VT);
    bf16_t* MIX = (bf16_t*)(ws + WS_MIX);
    float mq = 0.f, mk = 0.f;
    for (int i = 0; i < 64; ++i) { mq = fmaxf(mq, fabsf(p.qg[l * 64 + i])); mk = fmaxf(mk, fabsf(p.kg[l * 64 + i])); }
    const float negM = -(8.0f * 1.4426950408889634f) * mq * mk * 1.02f - 0.25f;
    const int nunits = 512 + (l == 0 ? 64 : 0);
    for (int u = blockIdx.x; u < nunits; u += gridDim.x) {
        const bool lat = u < 512;
        const int v = lat ? u : u - 512;
        const int b = lat ? (v >> 6) : (v >> 3), head = lat ? ((v >> 3) & 7) : (v & 7), qb = v & 7, kvh = head >> 2;
        const size_t qrow = (size_t)(b * 8 + head) * TKV + (lat ? 256 + qb * 512 : 0);
        const size_t orow = lat ? (size_t)(b * SEQ + qb * 512) : (size_t)(MX + b * CTX);
        attn_unit(QS + qrow * 64, KS + (size_t)(b * 2 + kvh) * TKV * 64, VT + (size_t)(b * 2 + kvh) * 64 * TKV, lat ? TKV / 64 : CTX / 64, lat ? 512 : 256,
                  MIX + orow * KOUT + head * 64, negM, lds, tid);
    }
}

#ifdef SKIP_GEMM
#define GEMMCALL if (0)
#else
#define GEMMCALL
#endif
__global__ void __launch_bounds__(NTHREADS, 2) mega(Params p) {
    extern __shared__ __attribute__((aligned(16))) unsigned char lds_raw[];
    LAS unsigned char* lds = (LAS unsigned char*)lds_raw;
    cg::grid_group grid = cg::this_grid();
    int tid = threadIdx.x; const int G = gridDim.x;
#define FRESH_TID() asm volatile("" : "+v"(tid))
    unsigned char* ws = p.ws;
    volatile LAS unsigned* xst = (volatile LAS unsigned*)(lds + LDS_BYTES - 64);
    if (tid < 16) xst[tid] = 0u;
    __syncthreads();
    XcdBarrier xb = xcd_barrier_post((unsigned*)(ws + WS_CTL) + 1024, xst);
    bf16_t* A1 = (bf16_t*)(ws + WS_A1); bf16_t* PX = (bf16_t*)(ws + WS_PX); bf16_t* MIX = (bf16_t*)(ws + WS_MIX); bf16_t* H = (bf16_t*)(ws + WS_H);
    float* XC = (float*)(ws + WS_XC);
#define GBAR() do { for (int rep = 0; rep < REP_BAR; ++rep) xcd_barrier(xb); } while (0)

#ifndef SKIP_PREP
    for (int rep = 0; rep < REP_PREP; ++rep) { FRESH_TID(); prep_phase(p, lds, tid, rep == 0 ? 31 : PREP_PROBE_MASK); }
#endif
    grid.sync();

    const float* GS = (const float*)(ws + WS_GS); float* RS = (float*)(ws + WS_RS);
    for (int l = 0; l < 2; ++l) {
        const float* modl = (const float*)(ws + WS_MOD) + (size_t)l * 9 * 6144;
        const float* xs = l == 0 ? p.x : p.out; const float* cs = l == 0 ? p.ctx : XC;
        const int Mres = l == 0 ? MT : MX;
        if (l == 0) {
            for (int rep = 0; rep < REP_NORM; ++rep) { FRESH_TID(); norm_phase(xs, cs, p.g1 + l * DM, modl, 0, A1, MT, tid); }
            FRESH_TID(); aux_phase(p, lds, tid);
            GBAR();
        }
        {
            pg8::Gemm g{A1, (const bf16_t*)(ws + WS_WIN) + (size_t)l * NIN * 1024, MT, NIN, 1024}; pg8::StaticOrder S; S.init(MT, NIN, G, (int)blockIdx.x);
            if (l == 0) { EpiStore<0> E{PX, NIN, 256}; GEMMCALL pg8::gemm_phase<EpiStore<0>, pg8::StaticOrder, true, true>(lds, g, S, E); }
            else { EpiStoreN<0> E{PX, NIN, RS + MT, (const float*)(ws + WS_SHW) + 131072, NIN}; GEMMCALL pg8::gemm_phase<EpiStoreN<0>, pg8::StaticOrder, true, true>(lds, g, S, E); }
        }
        GBAR();
        for (int rep = 0; rep < REP_POST; ++rep) { FRESH_TID(); post_phase(p, l, lds, tid); }
        GBAR();
        {
            for (int rep = 0; rep < REP_FOUR; ++rep) { FRESH_TID(); fft_phase(p, lds, tid); }
            if (l == 0) {
                pg8::Gemm g{(const bf16_t*)(ws + WS_CTC), (const bf16_t*)(ws + WS_ZTC), 256, 2048, 512}; pg8::StaticOrder S; S.init(256, 2048, G, (int)blockIdx.x);
                EpiStore<0> E{MIX + (size_t)MX * KOUT + 512, KOUT, (size_t)256 * KOUT};
                GEMMCALL pg8::gemm_phase<EpiStore<0>, pg8::StaticOrder, true, true>(lds, g, S, E);
            }
            __syncthreads();
            for (int rep = 0; rep < REP_ATTN; ++rep) { FRESH_TID(); attn_phase(p, l, lds, tid); }
        }
        GBAR();
        {
            pg8::Gemm g{MIX, (const bf16_t*)(ws + WS_WOUT) + (size_t)l * 1024 * KOUT, MX, 1024, KOUT}; pg8::StaticOrder S; S.init(MX, 1024, G, (int)blockIdx.x);
            EpiResid2 E{xs, cs, p.out, XC, modl + 2 * 1024, A1, GS + (size_t)(l * 2 + 1) * 9 * 1024, RS + (size_t)(l * 2) * MT};
            GEMMCALL pg8::gemm_phase<EpiResid2, pg8::StaticOrder, true, true>(lds, g, S, E);
            if (l == 0) for (int sub = G - 1 - (int)blockIdx.x; sub < 128; sub += G) {
                const int ks = sub & 3, un = sub >> 2;
                pg8::Gemm g2{MIX + (size_t)MX * KOUT + ks * 256, (const bf16_t*)(ws + WS_WOUT) + ks * 256, MC, 1024, 256, KOUT};
                OneUnit S2{true, un >> 2, un & 3};
                EpiSlab E2{(float*)(ws + WS_SLAB) + (size_t)ks * MC * DM};
                GEMMCALL pg8::gemm_phase<EpiSlab, OneUnit, true, true>(lds, g2, S2, E2);
            }
        }
        GBAR();
        if (l == 0) { FRESH_TID(); ctx_finish_phase(p, tid, 0); GBAR(); }
        {
            pg8::Gemm g{A1, (const bf16_t*)(ws + WS_W1) + (size_t)l * 4096 * 1024, Mres, DFF, 1024}; pg8::StaticOrder S; S.init(Mres, DFF, G, (int)blockIdx.x);
            EpiStoreN<1> E{H, DFF, RS + (size_t)(l * 2) * MT, (const float*)(ws + WS_SHW) + (size_t)l * 9 * 4096, 4096};
            GEMMCALL pg8::gemm_phase<EpiStoreN<1>, pg8::StaticOrder, true, true>(lds, g, S, E);
        }
        GBAR();
        {
            pg8::Gemm g{H, (const bf16_t*)(ws + WS_W2) + (size_t)l * 1024 * 4096, Mres, 1024, DFF}; pg8::StaticOrder S; S.init(Mres, 1024, G, (int)blockIdx.x);
            if (l == 0) {
                pg8::StaticOrder Sx; Sx.init(MX, 1024, G, (int)blockIdx.x);
                EpiResid2 E{p.out, XC, p.out, XC, modl + 5 * 1024, A1, GS + (size_t)(2) * 9 * 1024, RS + MT}; GEMMCALL pg8::gemm_phase<EpiResid2, pg8::StaticOrder, true, true>(lds, g, Sx, E);
                for (int sub = (int)blockIdx.x; sub < 128; sub += G) {
                    const int ks = sub & 3, un = sub >> 2;
                    pg8::Gemm g2{H + (size_t)MX * DFF + ks * 1024, (const bf16_t*)(ws + WS_W2) + ks * 1024, MC, 1024, 1024, DFF};
                    OneUnit S2{true, un >> 2, un & 3};
                    EpiSlab E2{(float*)(ws + WS_SLAB) + (size_t)ks * MC * DM};
                    GEMMCALL pg8::gemm_phase<EpiSlab, OneUnit, true, true>(lds, g2, S2, E2);
                }
            }
            else { EpiResid E{p.out, XC, p.out, XC, modl + 5 * 1024}; GEMMCALL pg8::gemm_phase<EpiResid, pg8::StaticOrder, true, true>(lds, g, S, E); }
        }
        if (l == 0) { GBAR(); FRESH_TID(); ctx_finish_phase(p, tid, 1); GBAR(); }
    }
}

extern "C" void kernel_launch(void* const* d_in, const int* in_sizes, int n_in, void* d_out, int out_size,
                              void* d_ws, size_t ws_size, hipStream_t stream) {
    static int grid_blocks = 0;
    if (!grid_blocks) {
        int dev = 0, cus = 0, per_cu = 0;
        hipGetDevice(&dev);
        hipDeviceGetAttribute(&cus, hipDeviceAttributeMultiprocessorCount, dev);
        hipFuncSetAttribute((const void*)mega, hipFuncAttributeMaxDynamicSharedMemorySize, LDS_BYTES);
        hipOccupancyMaxActiveBlocksPerMultiprocessor(&per_cu, (const void*)mega, NTHREADS, LDS_BYTES);
        if (per_cu < 1) fprintf(stderr, "kernel_launch: occupancy query reports %d workgroups per CU\n", per_cu);
        grid_blocks = cus;
        if (ws_size < WS_END) fprintf(stderr, "kernel_launch: workspace too small: %zu < %zu\n", ws_size, (size_t)WS_END);
    }
    Params p{};
    p.x = (const float*)d_in[0]; p.c = (const float*)d_in[1]; p.ctx = (const float*)d_in[2]; p.cctx = (const float*)d_in[3];
    p.w_ada = (const float*)d_in[4]; p.b_ada = (const float*)d_in[5]; p.g1 = (const float*)d_in[6]; p.g2 = (const float*)d_in[7];
    p.w_in = (const float*)d_in[8]; p.qg = (const float*)d_in[9]; p.kg = (const float*)d_in[10]; p.vg = (const float*)d_in[11];
    p.wsp = (const float*)d_in[12]; p.bsp = (const float*)d_in[13]; p.w_out = (const float*)d_in[14]; p.w1 = (const float*)d_in[15]; p.w2 = (const float*)d_in[16];
    p.out = (float*)d_out; p.ws = (unsigned char*)d_ws;
    hipMemsetAsync(d_ws, 0, WS_MOD + (size_t)2 * 9 * 6144 * sizeof(float), stream);
    void* args[] = {&p};
    hipError_t e = hipLaunchCooperativeKernel((void*)mega, dim3(grid_blocks), dim3(NTHREADS), args, LDS_BYTES, stream);
    if (e != hipSuccess) fprintf(stderr, "cooperative launch failed: %s (grid %d)\n", hipGetErrorString(e), grid_blocks);
}
```

```cpp
#include <hip/hip_runtime.h>
#include <hip/hip_cooperative_groups.h>
#include <cstdio>
#include <cstdint>
namespace cg = cooperative_groups;
namespace pg8 {
#define PG8_LAS __attribute__((address_space(3)))
typedef unsigned short bf16_t;
typedef short bf16x8 __attribute__((ext_vector_type(8)));
typedef float f32x4 __attribute__((ext_vector_type(4)));
typedef unsigned u32x4 __attribute__((ext_vector_type(4)));
constexpr int BM = 256, BK = 64, HALF = 128, HTB = HALF * BK * 2  , STAGE_BYTES = 8 * HTB, NXCD = 8, WGM = 8;

__host__ __device__ __forceinline__ int lds_byte(int r, int c) { const int st = (r >> 4) * 2 + (c >> 5), rr = r & 15, cc = c & 31, ob = rr * 64 + cc * 2; return st * 1024 + (ob ^ (((ob >> 9) & 1) << 5)); }
__host__ __device__ __forceinline__ void stage_rc(int b, int& R, int& C) { const int st = b / 1024, sb = b % 1024, swz = sb ^ (((sb >> 9) & 1) << 5); R = (st >> 1) * 16 + swz / 64; C = (st & 1) * 32 + (swz % 64) / 2; }
__host__ __device__ __forceinline__ int perm32(int rho) { const int n = rho >> 4, i = rho & 15; return 8 * (i >> 2) + 4 * n + (i & 3); }

struct Unit { int pm, pn; };
struct Gemm { const bf16_t* A; const bf16_t* Bt; int M, N, K; int ld; };

struct StaticOrder {
    int nM, nN, nwg, G, c;
    __host__ __device__ void init(int M, int N, int G_, int c_) { nM = M / BM; nN = N / BM; nwg = nM * nN; G = G_; c = c_; }
    __host__ __device__ bool next(int i, Unit& u) const {
        const long L = (long)i * G + c; if (L >= nwg) return false;
        int wgid = (int)L; { const int q = nwg / NXCD, r = nwg % NXCD, xcd = wgid % NXCD, off = wgid / NXCD; wgid = (xcd < r ? xcd * (q + 1) : r * (q + 1) + (xcd - r) * q) + off; }
        const int nig = WGM * nN, gid = wgid / nig, fm = gid * WGM, gsz = (nM - fm) < WGM ? (nM - fm) : WGM;
        u.pm = fm + ((wgid % nig) % gsz); u.pn = (wgid % nig) / gsz; return true;
    }
    __device__ __forceinline__ void a_ready(const Unit&) const {}
    __device__ __forceinline__ void done(const Unit&) const {}
};

__device__ __forceinline__ unsigned cvt_pk_bf16(float lo, float hi) { unsigned r; asm volatile("v_cvt_pk_bf16_f32 %0, %1, %2" : "=v"(r) : "v"(lo), "v"(hi)); return r; }
typedef float f32x2 __attribute__((ext_vector_type(2)));
template <class Epi, class Sched, bool ALIGN_EPI = false, bool SP2 = false>
__device__ __forceinline__ void gemm_phase(PG8_LAS unsigned char* lds, const Gemm g, const Sched& S, const Epi& E) {
    int tid_ = threadIdx.x; asm volatile("" : "+v"(tid_)); const int tid = tid_, wid = __builtin_amdgcn_readfirstlane(tid >> 6), lane = tid & 63, wr = wid >> 2, wc = wid & 3, fr = lane & 15, fq = lane >> 4;
    const int K = g.K, nt = K / BK, LD = g.ld ? g.ld : g.K;
    unsigned voffA[2], voffB[2];
#pragma unroll
    for (int i = 0; i < 2; ++i) { int R, C; stage_rc(tid * 16 + i * 8192, R, C); const int Rb = Epi::PERM ? ((R & ~31) + perm32(R & 31)) : R;
        voffA[i] = (unsigned)(R * LD + C) * 2u; voffB[i] = (unsigned)(Rb * LD + C) * 2u; }
    const size_t kstep = (size_t)(BK * 2);
    const size_t hstep = (size_t)HALF * LD * 2;
    const size_t tstep = 2 * hstep;
    const unsigned ldsw = (unsigned)wid * 1024u;
    const int aoff = lds_byte(wr * 64 + fr, fq * 8), boff = lds_byte(wc * 32 + fr, fq * 8);
#define PG8_SA(b, h) (((b) * 2 + (h)) * HTB)
#define PG8_SB(b, h) ((4 + (b) * 2 + (h)) * HTB)
#define PG8_STAGE(bufoff, gbase, voff) do { _Pragma("unroll") for (int _i = 0; _i < 2; ++_i) \
        __builtin_amdgcn_global_load_lds((const unsigned*)((const char*)(gbase) + (voff)[_i]), (PG8_LAS unsigned*)(lds + (bufoff) + ldsw + _i * 8192), 16, 0, 0); } while (0)
#define PG8_LDA(dst, b, h) do { _Pragma("unroll") for (int m = 0; m < 4; ++m) _Pragma("unroll") for (int k = 0; k < 2; ++k) dst[m][k] = *(const PG8_LAS bf16x8*)(lds + PG8_SA(b, h) + aoff + m * 2048 + k * 1024); } while (0)
#define PG8_LDB(dst, b, h) do { _Pragma("unroll") for (int n = 0; n < 2; ++n) _Pragma("unroll") for (int k = 0; k < 2; ++k) dst[n][k] = *(const PG8_LAS bf16x8*)(lds + PG8_SB(b, h) + boff + n * 2048 + k * 1024); } while (0)
#define PG8_MMA(ai, bj, At, Bt) do { __builtin_amdgcn_s_setprio(1); _Pragma("unroll") for (int m = 0; m < 4; ++m) _Pragma("unroll") for (int n = 0; n < 2; ++n) _Pragma("unroll") for (int k = 0; k < 2; ++k) \
        acc[ai][bj][m][n] = __builtin_amdgcn_mfma_f32_16x16x32_bf16(Bt[n][k], At[m][k], acc[ai][bj][m][n], 0, 0, 0); __builtin_amdgcn_s_setprio(0); } while (0)
#define PG8_WAIT_V(n) asm volatile("s_waitcnt vmcnt(" #n ")" ::: "memory")
#define PG8_WAIT_L(n) asm volatile("s_waitcnt lgkmcnt(" #n ")" ::: "memory")
#define PG8_BAR __builtin_amdgcn_s_barrier()
#define PG8_SCHED __builtin_amdgcn_sched_barrier(0)
    Unit cur, nxt; int ui = 0;
    if (!S.next(0, cur)) return;
    f32x4 acc[2][2][4][2];
#pragma unroll
    for (int a = 0; a < 2; ++a)
#pragma unroll
        for (int b = 0; b < 2; ++b)
#pragma unroll
            for (int m = 0; m < 4; ++m)
#pragma unroll
                for (int n = 0; n < 2; ++n) acc[a][b][m][n] = (f32x4){0.f, 0.f, 0.f, 0.f};
    bf16x8 At[4][2], B0[2][2], B1[2][2];
    const char* cA = (const char*)g.A + (size_t)cur.pm * tstep; const char* cB = (const char*)g.Bt + (size_t)cur.pn * tstep;
    S.a_ready(cur);
    if constexpr (SP2) {
        PG8_STAGE(PG8_SB(0, 0), cB, voffB); PG8_STAGE(PG8_SB(0, 1), cB + hstep, voffB); PG8_STAGE(PG8_SA(0, 0), cA, voffA); PG8_STAGE(PG8_SA(0, 1), cA + hstep, voffA);
        if (wr == 1) PG8_BAR;
        PG8_WAIT_V(2); PG8_BAR;
        PG8_STAGE(PG8_SB(1, 0), cB + kstep, voffB); PG8_STAGE(PG8_SA(1, 0), cA + kstep, voffA); PG8_STAGE(PG8_SB(1, 1), cB + hstep + kstep, voffB);
        PG8_WAIT_V(6); PG8_BAR;
    } else {
        PG8_STAGE(PG8_SB(0, 0), cB, voffB); PG8_STAGE(PG8_SA(0, 0), cA, voffA); PG8_STAGE(PG8_SB(0, 1), cB + hstep, voffB); PG8_STAGE(PG8_SA(0, 1), cA + hstep, voffA);
        if (wr == 1) PG8_BAR;
        PG8_WAIT_V(4); PG8_BAR;
        PG8_STAGE(PG8_SB(1, 0), cB + kstep, voffB); PG8_STAGE(PG8_SA(1, 0), cA + kstep, voffA); PG8_STAGE(PG8_SB(1, 1), cB + hstep + kstep, voffB);
        PG8_WAIT_V(6); PG8_BAR;
    }
    for (;;) {
        const bool has_next = S.next(ui + 1, nxt);
        const char* nA = has_next ? (const char*)g.A + (size_t)nxt.pm * tstep : cA; const char* nB = has_next ? (const char*)g.Bt + (size_t)nxt.pn * tstep : cB;
        for (int t = 0; t < nt; t += 2) {
            const bool last = (t == nt - 2);
            const char* a1 = cA + (size_t)(t + 1) * kstep;
            const char* a2 = last ? nA : cA + (size_t)(t + 2) * kstep; const char* b2 = last ? nB : cB + (size_t)(t + 2) * kstep;
            const char* a3 = a2 + kstep; const char* b3 = b2 + kstep;
            if (last && has_next) S.a_ready(nxt);
            if constexpr (SP2) {
            PG8_LDB(B0, 0, 0); PG8_LDB(B1, 0, 1); PG8_SCHED; PG8_LDA(At, 0, 0); PG8_STAGE(PG8_SA(1, 1), a1 + hstep, voffA);
            PG8_WAIT_V(8); PG8_WAIT_L(0); PG8_BAR; PG8_MMA(0, 0, At, B0); PG8_MMA(0, 1, At, B1); PG8_BAR; PG8_SCHED;
            PG8_LDA(At, 0, 1); PG8_STAGE(PG8_SB(0, 0), b2, voffB); PG8_STAGE(PG8_SB(0, 1), b2 + hstep, voffB); PG8_STAGE(PG8_SA(0, 0), a2, voffA);
            PG8_WAIT_V(8); PG8_WAIT_L(0); PG8_BAR; PG8_MMA(1, 0, At, B0); PG8_MMA(1, 1, At, B1); PG8_BAR; PG8_SCHED;
            PG8_LDB(B0, 1, 0); PG8_LDB(B1, 1, 1); PG8_SCHED; PG8_LDA(At, 1, 0); PG8_STAGE(PG8_SA(0, 1), a2 + hstep, voffA);
            PG8_WAIT_V(8); PG8_WAIT_L(0); PG8_BAR; PG8_MMA(0, 0, At, B0); PG8_MMA(0, 1, At, B1); PG8_BAR; PG8_SCHED;
            PG8_LDA(At, 1, 1); PG8_STAGE(PG8_SB(1, 0), b3, voffB); PG8_STAGE(PG8_SB(1, 1), b3 + hstep, voffB); PG8_STAGE(PG8_SA(1, 0), a3, voffA);
            PG8_WAIT_V(8); PG8_WAIT_L(0); PG8_BAR; PG8_MMA(1, 0, At, B0); PG8_MMA(1, 1, At, B1); PG8_BAR; PG8_SCHED;
            } else {
            PG8_LDB(B0, 0, 0); PG8_SCHED; PG8_LDA(At, 0, 0); PG8_STAGE(PG8_SA(1, 1), a1 + hstep, voffA);
            PG8_WAIT_L(8); PG8_BAR; PG8_WAIT_L(0); PG8_MMA(0, 0, At, B0); PG8_BAR; PG8_SCHED;
            PG8_LDB(B1, 0, 1); PG8_STAGE(PG8_SB(0, 0), b2, voffB);
            PG8_BAR; PG8_WAIT_L(0); PG8_MMA(0, 1, At, B1); PG8_BAR;
            PG8_LDA(At, 0, 1); PG8_STAGE(PG8_SA(0, 0), a2, voffA);
            PG8_BAR; PG8_WAIT_L(0); PG8_MMA(1, 0, At, B0); PG8_BAR; PG8_SCHED;
            PG8_STAGE(PG8_SB(0, 1), b2 + hstep, voffB);
            PG8_WAIT_V(6); PG8_BAR; PG8_MMA(1, 1, At, B1); PG8_BAR;
            PG8_LDB(B0, 1, 0); PG8_SCHED; PG8_LDA(At, 1, 0); PG8_STAGE(PG8_SA(0, 1), a2 + hstep, voffA);
            PG8_WAIT_L(8); PG8_BAR; PG8_WAIT_L(0); PG8_MMA(0, 0, At, B0); PG8_BAR; PG8_SCHED;
            PG8_LDB(B1, 1, 1); PG8_STAGE(PG8_SB(1, 0), b3, voffB);
            PG8_BAR; PG8_WAIT_L(0); PG8_MMA(0, 1, At, B1); PG8_BAR;
            PG8_LDA(At, 1, 1); PG8_STAGE(PG8_SA(1, 0), a3, voffA);
            PG8_BAR; PG8_WAIT_L(0); PG8_MMA(1, 0, At, B0); PG8_BAR; PG8_SCHED;
            PG8_STAGE(PG8_SB(1, 1), b3 + hstep, voffB);
            PG8_WAIT_V(6); PG8_BAR; PG8_MMA(1, 1, At, B1); PG8_BAR;
            }
        }
        if constexpr (ALIGN_EPI) { if (wr == 0) PG8_BAR; }
        if constexpr (!Epi::AFTER_DRAIN) { E(acc, cur, wr, wc, fr, fq); S.done(cur); }
        if (!has_next) break;
#pragma unroll
        for (int a = 0; a < 2; ++a)
#pragma unroll
            for (int b = 0; b < 2; ++b)
#pragma unroll
                for (int m = 0; m < 4; ++m)
#pragma unroll
                    for (int n = 0; n < 2; ++n) acc[a][b][m][n] = (f32x4){0.f, 0.f, 0.f, 0.f};
        cur = nxt; cA = nA; cB = nB; ++ui;
        if constexpr (ALIGN_EPI) { if (wr == 1) PG8_BAR; }
    }
    PG8_WAIT_V(0);
    if constexpr (!ALIGN_EPI) { if (wr == 0) PG8_BAR; }
    PG8_BAR;
    if constexpr (Epi::AFTER_DRAIN) { E.fused(acc, cur, wr, wc, fr, fq, lds, wid, lane); S.done(cur); }
#undef PG8_SA
#undef PG8_SB
#undef PG8_STAGE
#undef PG8_LDA
#undef PG8_LDB
#undef PG8_MMA
#undef PG8_WAIT_V
#undef PG8_WAIT_L
#undef PG8_BAR
#undef PG8_SCHED
}
}

#define LAS __attribute__((address_space(3)))
#define GAS __attribute__((address_space(1)))
using pg8::bf16_t; using pg8::f32x4; using pg8::bf16x8;
typedef float f32x16 __attribute__((ext_vector_type(16)));
typedef float f32x2v __attribute__((ext_vector_type(2)));
typedef __bf16 bf16x2v __attribute__((ext_vector_type(2)));
typedef unsigned u32x4 __attribute__((ext_vector_type(4)));
typedef unsigned u32x2 __attribute__((ext_vector_type(2)));

#ifndef REP_PREP
#define REP_PREP 1
#endif
#ifndef PREP_PROBE_MASK
#define PREP_PROBE_MASK 31
#endif
#ifndef REP_POST
#define REP_POST 1
#endif
#ifndef REP_ATTN
#define REP_ATTN 1
#endif
#ifndef REP_NORM
#define REP_NORM 1
#endif
#ifndef REP_FOUR
#define REP_FOUR 1
#endif
#ifndef REP_BAR
#define REP_BAR 1
#endif
constexpr int NTHREADS = 512;
constexpr int LDS_BYTES = 147456;
constexpr int NB = 8, SEQ = 4096, DM = 1024, CTX = 256, TKV = SEQ + CTX;
constexpr int MX = NB * SEQ, MC = NB * CTX, MT = MX + MC;
constexpr int NIN = 1792, KOUT = 1024, DFF = 4096;
constexpr size_t MiB = 1u << 20;
constexpr size_t WS_CTL = 0, WS_MOD = 1 * MiB, WS_ROPE = 2 * MiB, WS_WIN = 4 * MiB, WS_WOUT = 12 * MiB, WS_W1 = 18 * MiB, WS_W2 = 34 * MiB,
                 WS_CT = 50 * MiB, WS_ST = 82 * MiB, WS_CTC = 114 * MiB, WS_WSB = 115 * MiB, WS_XC = 116 * MiB, WS_A1 = 124 * MiB,
                 WS_PX = 192 * MiB, WS_QS = 311 * MiB, WS_KS = 345 * MiB, WS_VT = 354 * MiB, WS_ZT = 363 * MiB, WS_ZTC = 395 * MiB,
                 WS_MIX = 397 * MiB, WS_H = 192 * MiB, WS_END = 482 * MiB,
                 WS_FA = 50 * MiB, WS_FB = 51 * MiB, WS_TW = 52 * MiB, WS_GS = 53 * MiB, WS_SHW = 54 * MiB, WS_RS = 55 * MiB, WS_SLAB = 58 * MiB;
constexpr float QSCALE = 0.125f * 1.4426950408889634f;

struct Params {
    const float *x, *c, *ctx, *cctx, *w_ada, *b_ada, *g1, *g2, *w_in, *qg, *kg, *vg, *wsp, *bsp, *w_out, *w1, *w2;
    float* out; unsigned char* ws;
};

__device__ __forceinline__ unsigned pk2(float lo, float hi) { f32x2v v = {lo, hi}; bf16x2v b = __builtin_convertvector(v, bf16x2v); return __builtin_bit_cast(unsigned, b); }
__device__ __forceinline__ unsigned short f2bf(float f) { return (unsigned short)(pk2(f, 0.f) & 0xffffu); }
__device__ __forceinline__ float bf2f(unsigned short h) { return __uint_as_float(((unsigned)h) << 16); }
__device__ __forceinline__ float gelu_t(float x) { const float t = x * (-2.3022082f + -0.10294324f * x * x); return x * __builtin_amdgcn_rcpf(1.0f + __builtin_amdgcn_exp2f(t)); }
__device__ __forceinline__ void unpack8(const u32x4 v, float (&y)[8]) {
    y[0] = __uint_as_float(v.x << 16); y[1] = __uint_as_float(v.x & 0xffff0000u); y[2] = __uint_as_float(v.y << 16); y[3] = __uint_as_float(v.y & 0xffff0000u);
    y[4] = __uint_as_float(v.z << 16); y[5] = __uint_as_float(v.z & 0xffff0000u); y[6] = __uint_as_float(v.w << 16); y[7] = __uint_as_float(v.w & 0xffff0000u);
}
__device__ __forceinline__ float dpp_xor1(float v) { return __builtin_bit_cast(float, __builtin_amdgcn_update_dpp(0, __builtin_bit_cast(int, v), 0xB1, 0xF, 0xF, true)); }
__device__ __forceinline__ float dpp_xor2(float v) { return __builtin_bit_cast(float, __builtin_amdgcn_update_dpp(0, __builtin_bit_cast(int, v), 0x4E, 0xF, 0xF, true)); }
__device__ __forceinline__ float dpp_mirror8(float v) { return __builtin_bit_cast(float, __builtin_amdgcn_update_dpp(0, __builtin_bit_cast(int, v), 0x141, 0xF, 0xF, true)); }
__device__ __forceinline__ float sum8(float s) { s += dpp_xor1(s); s += dpp_xor2(s); s += dpp_mirror8(s); return s; }
__device__ __forceinline__ float wave_sum(float v) {
#pragma unroll
    for (int o = 1; o < 64; o <<= 1) v += __shfl_xor(v, o);
    return v;
}

#define XB_TMO      128
#define XB_XCNT(j)  (256  + 64 * (j))
#define XB_XSUB(j)  (1280 + 64 * (j))
#define XB_XGEN(j)  (2304 + 64 * (j))
#define XB_TOP      3328
#define XB_TOPGEN   3392
#define XCD_BAR_WORDS 3456
#define XB_SPIN_CAP (1u << 18)

__device__ __forceinline__ unsigned xb_ld(unsigned* p)              { return __hip_atomic_load(p, __ATOMIC_RELAXED, __HIP_MEMORY_SCOPE_AGENT); }
__device__ __forceinline__ unsigned xb_add(unsigned* p, unsigned v) { return __hip_atomic_fetch_add(p, v, __ATOMIC_RELAXED, __HIP_MEMORY_SCOPE_AGENT); }
__device__ __forceinline__ unsigned xb_xcc_id() { return (unsigned)__builtin_amdgcn_s_getreg((3 << 11) | 20) & 0xFu; }
#define XB_SPIN(cond, bar) do { unsigned _sp = 0; while (cond) { __builtin_amdgcn_s_sleep(1); \
    if ((++_sp & 255u) == 0u) { if (xb_ld(&(bar)[XB_TMO])) break; if (_sp > XB_SPIN_CAP) { atomicAdd(&(bar)[XB_TMO], 1u); break; } } } } while (0)

struct XcdBarrier {
    unsigned* bar; unsigned x;
    volatile LAS unsigned* st;
};

__device__ __forceinline__ XcdBarrier xcd_barrier_post(unsigned* bar, volatile LAS unsigned* st) {
    XcdBarrier b; b.bar = bar; b.x = xb_xcc_id(); b.st = st;
    if (threadIdx.x == 0) (void)xb_add(&bar[XB_XCNT(b.x)], 1u);
    return b;
}
__device__ __forceinline__ void xcd_barrier_complete(unsigned* bar, unsigned x, unsigned& nloc, unsigned& nx) {
    const unsigned G = gridDim.x * gridDim.y * gridDim.z;
    unsigned sum, cnt, mine, sp = 0u;
    for (;;) {
        sum = 0u; cnt = 0u; mine = 0u;
#pragma unroll
        for (unsigned j = 0; j < 16; ++j) { const unsigned c = xb_ld(&bar[XB_XCNT(j)]); sum += c; cnt += (c > 0u) ? 1u : 0u; mine = (j == x) ? c : mine; }
        if (sum == G) break;
        __builtin_amdgcn_s_sleep(1);
        if ((++sp & 255u) == 0u) { if (xb_ld(&bar[XB_TMO])) break; if (sp > XB_SPIN_CAP) { atomicAdd(&bar[XB_TMO], 1u); break; } }
    }
    nloc = mine > 0u ? mine : 1u; nx = cnt > 0u ? cnt : 1u;
}

__device__ __forceinline__ void xcd_barrier(const XcdBarrier& b) {
    asm volatile("s_waitcnt vmcnt(0)" ::: "memory");
    __syncthreads();
    if (threadIdx.x == 0) {
        unsigned* bar = b.bar;
        __builtin_amdgcn_s_waitcnt(0);
        unsigned nloc = b.st[0], nx = b.st[1];
        if (nloc == 0u) { xcd_barrier_complete(bar, b.x, nloc, nx); b.st[0] = nloc; b.st[1] = nx; }
        const unsigned old = xb_add(&bar[XB_XSUB(b.x)], 1u);
        const unsigned gen = old / nloc;
        if (old + 1u == (gen + 1u) * nloc) {
            __builtin_amdgcn_fence(__ATOMIC_RELEASE, "agent");
            asm volatile("s_waitcnt vmcnt(0)" ::: "memory");
            const unsigned og = xb_add(&bar[XB_TOP], 1u);
            const unsigned tg = og / nx;
            if (og + 1u == (tg + 1u) * nx) xb_add(&bar[XB_TOPGEN], 1u);
            else XB_SPIN(xb_ld(&bar[XB_TOPGEN]) == tg, bar);
            __builtin_amdgcn_fence(__ATOMIC_ACQUIRE, "agent");
            xb_add(&bar[XB_XGEN(b.x)], 1u);
            asm volatile("s_waitcnt vmcnt(0)" ::: "memory");
        } else {
            XB_SPIN(xb_ld(&bar[XB_XGEN(b.x)]) == gen, bar);
            __builtin_amdgcn_fence(__ATOMIC_ACQUIRE, "agent");
            asm volatile("s_waitcnt vmcnt(0)" ::: "memory");
        }
    }
    __syncthreads();
}

__device__ __forceinline__ void grid_barrier(unsigned* bar, unsigned& gen) {
    asm volatile("s_waitcnt vmcnt(0)" ::: "memory");
    __syncthreads();
    if (threadIdx.x == 0) {
        gen += gridDim.x;
        __threadfence();
        __hip_atomic_fetch_add(bar, 1u, __ATOMIC_RELAXED, __HIP_MEMORY_SCOPE_AGENT);
        while (__hip_atomic_load(bar, __ATOMIC_RELAXED, __HIP_MEMORY_SCOPE_AGENT) < gen) __builtin_amdgcn_s_sleep(2);
        __threadfence();
    }
    __syncthreads();
}

template <int ACT> struct EpiStore {
    static constexpr bool PERM = true, AFTER_DRAIN = false;
    bf16_t* O; int ldc; size_t pnoff;
    __device__ __forceinline__ void operator()(const f32x4 (&acc)[2][2][4][2], const pg8::Unit& u, int wr, int wc, int fr, int fq) const {
        const int row0 = u.pm * 256 + wr * 64 + fr;
        bf16_t* base = O + (size_t)u.pn * pnoff + wc * 32 + 8 * fq;
#pragma unroll
        for (int ai = 0; ai < 2; ++ai)
#pragma unroll
            for (int m = 0; m < 4; ++m) {
                bf16_t* rowp = base + (size_t)(row0 + ai * 128 + m * 16) * ldc;
#pragma unroll
                for (int bj = 0; bj < 2; ++bj) {
                    f32x4 v0 = acc[ai][bj][m][0], v1 = acc[ai][bj][m][1];
                    if (ACT == 1) {
#pragma unroll
                        for (int e = 0; e < 4; ++e) { const float a = fmaxf(v0[e], 0.f), b = fmaxf(v1[e], 0.f); v0[e] = a * a; v1[e] = b * b; }
                    }
                    u32x4 w; w.x = pk2(v0[0], v0[1]); w.y = pk2(v0[2], v0[3]); w.z = pk2(v1[0], v1[1]); w.w = pk2(v1[2], v1[3]);
                    *(u32x4*)(rowp + bj * 128) = w;
                }
            }
    }
};
struct EpiResid {
    static constexpr bool PERM = true, AFTER_DRAIN = false;
    const float* xbase; const float* cbase; float* xout; float* cout; const float* gate;
    __device__ __forceinline__ void operator()(const f32x4 (&acc)[2][2][4][2], const pg8::Unit& u, int wr, int wc, int fr, int fq) const {
        const int R0 = u.pm * 256; const bool isx = R0 < MX;
        const float* base = isx ? xbase + (size_t)R0 * DM : cbase + (size_t)(R0 - MX) * DM;
        float* out = isx ? xout + (size_t)R0 * DM : cout + (size_t)(R0 - MX) * DM;
        const int bp = isx ? (R0 >> 12) : 8;
        const float* gtp = gate + (size_t)bp * 6144 + u.pn * 256;
        const unsigned cl = (unsigned)(wc * 32 + 8 * fq);
        const unsigned colg = (unsigned)(u.pn * 256) + cl;
        f32x4 gv[2][2];
#pragma unroll
        for (int bj = 0; bj < 2; ++bj)
#pragma unroll
            for (int n = 0; n < 2; ++n) gv[bj][n] = *(const f32x4*)(gtp + (cl + bj * 128 + n * 4));
#pragma unroll
        for (int ai = 0; ai < 2; ++ai)
#pragma unroll
            for (int mp = 0; mp < 2; ++mp) {
                f32x4 bs[2][2][2];
#pragma unroll
                for (int mm = 0; mm < 2; ++mm)
#pragma unroll
                    for (int bj = 0; bj < 2; ++bj)
#pragma unroll
                        for (int n = 0; n < 2; ++n)
                            bs[mm][bj][n] = *(const f32x4*)(base + ((unsigned)(ai * 128 + wr * 64 + (2 * mp + mm) * 16 + fr) * (unsigned)DM + colg + bj * 128 + n * 4));
#pragma unroll
                for (int mm = 0; mm < 2; ++mm) {
                    const int m = 2 * mp + mm;
                    const unsigned off = (unsigned)(ai * 128 + wr * 64 + m * 16 + fr) * (unsigned)DM + colg;
#pragma unroll
                    for (int bj = 0; bj < 2; ++bj)
#pragma unroll
                        for (int n = 0; n < 2; ++n)
                            *(f32x4*)(out + (off + bj * 128 + n * 4)) = bs[mm][bj][n] + gv[bj][n] * acc[ai][bj][m][n];
                }
                asm volatile("" ::: "memory");
            }
    }
};

struct EpiResid2 {
    static constexpr bool PERM = true, AFTER_DRAIN = false;
    const float* xbase; const float* cbase; float* xout; float* cout; const float* gate; bf16_t* A1; const float* gs; float* rs;
    __device__ __forceinline__ void operator()(const f32x4 (&acc)[2][2][4][2], const pg8::Unit& u, int wr, int wc, int fr, int fq) const {
        const int R0 = u.pm * 256; const bool isx = R0 < MX;
        const float* base = isx ? xbase + (size_t)R0 * DM : cbase + (size_t)(R0 - MX) * DM;
        float* out = isx ? xout + (size_t)R0 * DM : cout + (size_t)(R0 - MX) * DM;
        const int bp = isx ? (R0 >> 12) : 8;
        const float* gtp = gate + (size_t)bp * 6144 + u.pn * 256;
        const float* gsp = gs + (size_t)bp * DM + u.pn * 256;
        bf16_t* a1p = A1 + (size_t)R0 * DM;
        float* rsp = rs + R0;
        const unsigned cl = (unsigned)(wc * 32 + 8 * fq);
        const unsigned colg = (unsigned)(u.pn * 256) + cl;
        f32x4 gv[2][2];
#pragma unroll
        for (int bj = 0; bj < 2; ++bj)
#pragma unroll
            for (int n = 0; n < 2; ++n) gv[bj][n] = *(const f32x4*)(gtp + (cl + bj * 128 + n * 4));
#pragma unroll
        for (int ai = 0; ai < 2; ++ai)
#pragma unroll
            for (int mp = 0; mp < 2; ++mp) {
                f32x4 bs[2][2][2], gsv[2][2];
#pragma unroll
                for (int bj = 0; bj < 2; ++bj)
#pragma unroll
                    for (int n = 0; n < 2; ++n) gsv[bj][n] = *(const f32x4*)(gsp + (cl + bj * 128 + n * 4));
#pragma unroll
                for (int mm = 0; mm < 2; ++mm)
#pragma unroll
                    for (int bj = 0; bj < 2; ++bj)
#pragma unroll
                        for (int n = 0; n < 2; ++n)
                            bs[mm][bj][n] = *(const f32x4*)(base + ((unsigned)(ai * 128 + wr * 64 + (2 * mp + mm) * 16 + fr) * (unsigned)DM + colg + bj * 128 + n * 4));
#pragma unroll
                for (int mm = 0; mm < 2; ++mm) {
                    const int m = 2 * mp + mm;
                    const unsigned r = (unsigned)(ai * 128 + wr * 64 + m * 16 + fr);
                    const unsigned off = r * (unsigned)DM + colg;
                    float ssq = 0.f;
#pragma unroll
                    for (int bj = 0; bj < 2; ++bj) {
                        const f32x4 o0 = bs[mm][bj][0] + gv[bj][0] * acc[ai][bj][m][0], o1 = bs[mm][bj][1] + gv[bj][1] * acc[ai][bj][m][1];
                        *(f32x4*)(out + (off + bj * 128)) = o0; *(f32x4*)(out + (off + bj * 128 + 4)) = o1;
                        ssq += (o0[0] * o0[0] + o0[1] * o0[1]) + (o0[2] * o0[2] + o0[3] * o0[3]) + (o1[0] * o1[0] + o1[1] * o1[1]) + (o1[2] * o1[2] + o1[3] * o1[3]);
                        const f32x4 a0 = o0 * gsv[bj][0], a1 = o1 * gsv[bj][1];
                        *(u32x4*)(a1p + (off + bj * 128)) = (u32x4){pk2(a0[0], a0[1]), pk2(a0[2], a0[3]), pk2(a1[0], a1[1]), pk2(a1[2], a1[3])};
                    }
                    ssq += __shfl_xor(ssq, 16); ssq += __shfl_xor(ssq, 32);
                    if (fq == 0) atomicAdd(rsp + r, ssq);
                }
                asm volatile("" ::: "memory");
            }
    }
};
template <int ACT> struct EpiStoreN {
    static constexpr bool PERM = true, AFTER_DRAIN = false;
    bf16_t* O; int ldc; const float* rs; const float* shw; int shld;
    __device__ __forceinline__ void operator()(const f32x4 (&acc)[2][2][4][2], const pg8::Unit& u, int wr, int wc, int fr, int fq) const {
        const int R0 = u.pm * 256; const int bp = R0 < MX ? (R0 >> 12) : 8;
        const unsigned rl = (unsigned)(wr * 64 + fr);
        const unsigned colb = (unsigned)(u.pn * 256 + wc * 32 + 8 * fq);
        const float* svp = shw + (size_t)bp * shld;
        const float* rsp = rs + R0;
        bf16_t* base = O + (size_t)R0 * ldc;
        f32x4 sv[2][2]; float rstd[2][4];
#pragma unroll
        for (int bj = 0; bj < 2; ++bj)
#pragma unroll
            for (int n = 0; n < 2; ++n) sv[bj][n] = *(const f32x4*)(svp + (colb + bj * 128 + n * 4));
#pragma unroll
        for (int ai = 0; ai < 2; ++ai)
#pragma unroll
            for (int m = 0; m < 4; ++m) rstd[ai][m] = rsp[rl + ai * 128 + m * 16];
#pragma unroll
        for (int ai = 0; ai < 2; ++ai)
#pragma unroll
            for (int m = 0; m < 4; ++m) {
                const float rr = rsqrtf(rstd[ai][m] * (1.0f / 1024.0f) + 1e-6f);
                const unsigned off = (rl + ai * 128 + m * 16) * (unsigned)ldc + colb;
#pragma unroll
                for (int bj = 0; bj < 2; ++bj) {
                    f32x4 v0 = acc[ai][bj][m][0] * rr + sv[bj][0], v1 = acc[ai][bj][m][1] * rr + sv[bj][1];
                    if (ACT == 1) {
#pragma unroll
                        for (int e = 0; e < 4; ++e) { const float a = fmaxf(v0[e], 0.f), b = fmaxf(v1[e], 0.f); v0[e] = a * a; v1[e] = b * b; }
                    }
                    u32x4 w; w.x = pk2(v0[0], v0[1]); w.y = pk2(v0[2], v0[3]); w.z = pk2(v1[0], v1[1]); w.w = pk2(v1[2], v1[3]);
                    *(u32x4*)(base + (off + bj * 128)) = w;
                }
            }
    }
};

struct EpiSlab {
    static constexpr bool PERM = false, AFTER_DRAIN = false;
    float* slab;
    __device__ __forceinline__ void operator()(const f32x4 (&acc)[2][2][4][2], const pg8::Unit& u, int wr, int wc, int fr, int fq) const {
        float* base = slab + (size_t)u.pm * 256 * DM + u.pn * 256;
        const unsigned cl = (unsigned)(wc * 32 + 4 * fq);
#pragma unroll
        for (int ai = 0; ai < 2; ++ai)
#pragma unroll
            for (int m = 0; m < 4; ++m) {
                const unsigned off = (unsigned)(ai * 128 + wr * 64 + m * 16 + fr) * (unsigned)DM + cl;
#pragma unroll
                for (int bj = 0; bj < 2; ++bj)
#pragma unroll
                    for (int n = 0; n < 2; ++n) *(f32x4*)(base + (off + bj * 128 + n * 16)) = acc[ai][bj][m][n];
            }
    }
};
struct OneUnit {
    bool has; int pm, pn;
    __device__ bool next(int i, pg8::Unit& u) const { if (i != 0 || !has) return false; u.pm = pm; u.pn = pn; return true; }
    __device__ __forceinline__ void a_ready(const pg8::Unit&) const {}
    __device__ __forceinline__ void done(const pg8::Unit&) const {}
};

__device__ __forceinline__ void tr_tile(const float* src, int ldn, int k0, int n0, bf16_t* dst, int ldd, int drow0, int dcol0, int dcol1, LAS float* t, int tid) {
    {
        const int r = tid >> 3, cs = (tid & 7) * 8;
        const f32x4* s = (const f32x4*)(src + (size_t)(k0 + r) * ldn + n0 + cs);
        const f32x4 a = s[0], b = s[1];
        LAS float* tr = t + r * 65 + cs;
        tr[0] = a[0]; tr[1] = a[1]; tr[2] = a[2]; tr[3] = a[3]; tr[4] = b[0]; tr[5] = b[1]; tr[6] = b[2]; tr[7] = b[3];
    }
    __syncthreads();
    {
        const int n = tid >> 3, kc = (tid & 7) * 8;
        const LAS float* s = t + kc * 65 + n;
        u32x4 o; o.x = pk2(s[0], s[65]); o.y = pk2(s[2 * 65], s[3 * 65]); o.z = pk2(s[4 * 65], s[5 * 65]); o.w = pk2(s[6 * 65], s[7 * 65]);
        *(u32x4*)(dst + (size_t)(drow0 + n) * ldd + dcol0 + kc) = o;
        if (dcol1 >= 0) *(u32x4*)(dst + (size_t)(drow0 + n) * ldd + dcol1 + kc) = o;
    }
    __syncthreads();
}

__device__ __forceinline__ void prep_phase(const Params& p, LAS unsigned char* lds, int tid, int mask) {
    const int G = gridDim.x, bx = blockIdx.x;
    unsigned char* ws = p.ws;
    LAS float* lf = (LAS float*)lds;
    if (mask & 1) for (int u = bx; u < 192; u += G) {
        const int l = u / 96, r = u % 96, cbk = r >> 2, kq = r & 3;
        LAS float* sc = lf;
        LAS float* red = lf + 4096;
        for (int i = tid; i < 9 * 256; i += NTHREADS) {
            const int b = i >> 8, k = kq * 256 + (i & 255);
            const float v = b < 8 ? p.c[b * 1024 + k] : p.cctx[k];
            sc[i] = v / (1.0f + __expf(-v));
        }
        __syncthreads();
        const int lane = tid & 63, w = tid >> 6, col4 = lane * 4;
        const float* wp = p.w_ada + (size_t)l * 1024 * 6144 + (size_t)(kq * 256 + w * 32) * 6144 + cbk * 256 + col4;
        f32x4 acc[9];
#pragma unroll
        for (int b = 0; b < 9; ++b) acc[b] = (f32x4){0.f, 0.f, 0.f, 0.f};
        for (int h = 0; h < 2; ++h) {
            f32x4 wv[16];
#pragma unroll
            for (int j = 0; j < 16; ++j) wv[j] = __builtin_nontemporal_load((const f32x4*)(wp + (size_t)(h * 16 + j) * 6144));
#pragma unroll
            for (int j = 0; j < 16; ++j) {
                const int kl = w * 32 + h * 16 + j;
#pragma unroll
                for (int b = 0; b < 9; ++b) acc[b] += wv[j] * sc[b * 256 + kl];
            }
        }
#pragma unroll
        for (int b = 0; b < 9; ++b) *(LAS f32x4*)(red + (w * 9 + b) * 256 + col4) = acc[b];
        __syncthreads();
        for (int i = tid; i < 9 * 256; i += NTHREADS) {
            const int b = i >> 8, jj = i & 255; float sum = 0.f;
#pragma unroll
            for (int g8 = 0; g8 < 8; ++g8) sum += red[(g8 * 9 + b) * 256 + jj];
            if (kq == 0) sum += p.b_ada[l * 6144 + cbk * 256 + jj];
            atomicAdd((float*)(ws + WS_MOD) + (size_t)(l * 9 + b) * 6144 + cbk * 256 + jj, sum);
        }
        __syncthreads();
    }
    if (mask & 2) for (int u = (bx + 1) % G; u < 1; u += G) {
        LAS unsigned short* tc = (LAS unsigned short*)lds; LAS unsigned short* tsn = tc + 4096;
        for (int i = tid; i < 256; i += NTHREADS) { float s, c; sincospif((float)i * (1.0f / 128.0f), &s, &c); tc[i] = f2bf(c * (1.0f / 128.0f)); tsn[i] = f2bf(s * (1.0f / 128.0f)); }
        __syncthreads();
        bf16_t* CTC = (bf16_t*)(ws + WS_CTC); bf16_t* STC = CTC + 256;
        for (int c = tid; c < 256 * 32; c += NTHREADS) {
            const int k = c >> 5, n0 = (c & 31) * 8;
            unsigned idx = ((unsigned)k * (unsigned)n0) & 255u;
            unsigned cw[4], sw[4];
#pragma unroll
            for (int e = 0; e < 4; ++e) {
                const unsigned i0 = idx; idx = (idx + k) & 255u; const unsigned i1 = idx; idx = (idx + k) & 255u;
                cw[e] = (unsigned)tc[i0] | ((unsigned)tc[i1] << 16); sw[e] = (unsigned)tsn[i0] | ((unsigned)tsn[i1] << 16);
            }
            *(u32x4*)(CTC + (size_t)k * 512 + n0) = (u32x4){cw[0], cw[1], cw[2], cw[3]};
            *(u32x4*)(STC + (size_t)k * 512 + n0) = (u32x4){sw[0], sw[1], sw[2], sw[3]};
        }
        __syncthreads();
    }
    {
        const int gt = bx * NTHREADS + tid;
        if (gt < 16384) {
            const int row = gt >> 7, kk = gt & 127, ro = row >> 6, k1 = row & 63, ri = kk >> 6, n1 = kk & 63;
            float sn, cs; sincospif((float)((n1 * k1) & 63) * (1.0f / 32.0f), &sn, &cs);
            const float v = (ro == ri) ? cs : (ro == 0 ? sn : -sn);
            ((bf16_t*)(ws + WS_FA))[gt] = f2bf(v * 0.125f);
        } else if (gt < 16384 + 8192) {
            const int q = gt - 16384, k2 = q >> 7, kk = q & 127, ro = kk >> 6, n2 = kk & 63;
            float sn, cs; sincospif((float)((n2 * k2) & 63) * (1.0f / 32.0f), &sn, &cs);
            ((bf16_t*)(ws + WS_FB))[q] = f2bf((ro == 0 ? cs : sn) * (1.0f / 64.0f));
        } else if (gt < 16384 + 8192 + 4096) {
            const int q = gt - 24576, n2 = q >> 6, k1 = q & 63;
            float sn, cs; sincospif((float)(n2 * k1) * (1.0f / 2048.0f), &sn, &cs);
            ((float*)(ws + WS_TW))[q * 2] = cs; ((float*)(ws + WS_TW))[q * 2 + 1] = sn;
        }
    }
    const int nfb = G < 64 ? G : 64;
    if (mask & 4) for (int u = bx - (G - nfb); u >= 0 && u < 128; u += nfb) {
        const int l = u >> 6, g = (u >> 4) & 3, k0 = (u & 15) * 64;
        LAS float* t = lf; LAS float* ctab = lf + 64 * 65; LAS float* stab = ctab + 64;
        {
            const int r = tid >> 3, cs = (tid & 7) * 8;
            const f32x4* s = (const f32x4*)(p.w_in + (size_t)l * 1024 * 1536 + (size_t)(k0 + r) * 1536 + 768 + g * 64 + cs);
            const f32x4 a = __builtin_nontemporal_load(s), b = __builtin_nontemporal_load(s + 1);
            LAS float* tr = t + r * 65 + cs;
            tr[0] = a[0]; tr[1] = a[1]; tr[2] = a[2]; tr[3] = a[3]; tr[4] = b[0]; tr[5] = b[1]; tr[6] = b[2]; tr[7] = b[3];
        }
        if (tid < 64) { float s, c; sincospif((float)tid * (1.0f / 32.0f), &s, &c); ctab[tid] = c; stab[tid] = s; }
        __syncthreads();
        const int k = tid & 63, cg8 = tid >> 6;
        bf16_t* WIN = (bf16_t*)(ws + WS_WIN) + (size_t)l * NIN * 1024;
        for (int j = 0; j < 8; ++j) {
            const int cp = cg8 + 8 * j; float re = 0.f, im = 0.f;
#pragma unroll 8
            for (int c = 0; c < 64; ++c) { const float w = t[k * 65 + c]; const int idx = (c * cp) & 63; re += w * ctab[idx]; im -= w * stab[idx]; }
            WIN[(size_t)(768 + g * 128 + cp) * 1024 + k0 + k] = f2bf(re);
            WIN[(size_t)(768 + g * 128 + 64 + cp) * 1024 + k0 + k] = f2bf(im);
        }
        __syncthreads();
    }
    if (mask & 8) for (int u0 = bx * 4; u0 < 5248; u0 += G * 4) {
        const float* src[4]; bf16_t* dst[4]; int ldn[4], ldd[4];
#pragma unroll
        for (int j = 0; j < 4; ++j) {
            const int u = u0 + j, l = u / 2624; int r = u % 2624;
            if (r < 320) { const int kt = r / 20, jj = r % 20, nt = jj < 12 ? jj : jj + 4;
                src[j] = p.w_in + (size_t)l * 1024 * 1536 + (size_t)(kt * 64) * 1536 + nt * 64; ldn[j] = 1536;
                dst[j] = (bf16_t*)(ws + WS_WIN) + (size_t)l * NIN * 1024 + (size_t)(jj < 12 ? nt * 64 : nt * 64 + 256) * 1024 + kt * 64; ldd[j] = 1024; }
            else if (r < 576) { r -= 320; const int kt = r / 16, nt = r % 16;
                src[j] = p.w_out + (size_t)l * 1024 * 1024 + (size_t)(kt * 64) * 1024 + nt * 64; ldn[j] = 1024;
                dst[j] = (bf16_t*)(ws + WS_WOUT) + (size_t)l * 1024 * KOUT + (size_t)(nt * 64) * KOUT + kt * 64; ldd[j] = KOUT; }
            else if (r < 1600) { r -= 576; const int kt = r / 64, nt = r % 64;
                src[j] = p.w1 + (size_t)l * 1024 * 4096 + (size_t)(kt * 64) * 4096 + nt * 64; ldn[j] = 4096;
                dst[j] = (bf16_t*)(ws + WS_W1) + (size_t)l * 4096 * 1024 + (size_t)(nt * 64) * 1024 + kt * 64; ldd[j] = 1024; }
            else { r -= 1600; const int kt = r / 16, nt = r % 16;
                src[j] = p.w2 + (size_t)l * 4096 * 1024 + (size_t)(kt * 64) * 1024 + nt * 64; ldn[j] = 1024;
                dst[j] = (bf16_t*)(ws + WS_W2) + (size_t)l * 1024 * 4096 + (size_t)(nt * 64) * 4096 + kt * 64; ldd[j] = 4096; }
        }
        f32x4 a[4], b[4];
        {
            const int r = tid >> 3, cs = (tid & 7) * 8;
#pragma unroll
            for (int j = 0; j < 4; ++j) { const f32x4* sp = (const f32x4*)(src[j] + (size_t)r * ldn[j] + cs); a[j] = __builtin_nontemporal_load(sp); b[j] = __builtin_nontemporal_load(sp + 1); }
#pragma unroll
            for (int j = 0; j < 4; ++j) {
                LAS float* tr = lf + j * (64 * 65) + r * 65 + cs;
                tr[0] = a[j][0]; tr[1] = a[j][1]; tr[2] = a[j][2]; tr[3] = a[j][3]; tr[4] = b[j][0]; tr[5] = b[j][1]; tr[6] = b[j][2]; tr[7] = b[j][3];
            }
        }
        __syncthreads();
        {
            const int n = tid >> 3, kc = (tid & 7) * 8;
#pragma unroll
            for (int j = 0; j < 4; ++j) {
                const LAS float* sp = lf + j * (64 * 65) + kc * 65 + n;
                u32x4 o; o.x = pk2(sp[0], sp[65]); o.y = pk2(sp[2 * 65], sp[3 * 65]); o.z = pk2(sp[4 * 65], sp[5 * 65]); o.w = pk2(sp[6 * 65], sp[7 * 65]);
                *(u32x4*)(dst[j] + (size_t)n * ldd[j] + kc) = o;
            }
        }
        __syncthreads();
    }
    {
        const int gt = bx * NTHREADS + tid, GT = G * NTHREADS;
        for (int i = gt; i < 3 * MT; i += GT) ((float*)(ws + WS_RS))[i] = 0.f;
        bf16_t* WSB = (bf16_t*)(ws + WS_WSB);
        for (int i = gt; i < 2 * 4 * 128 * 128 / 8; i += GT) {
            const f32x4 a = *(const f32x4*)(p.wsp + (size_t)i * 8), b = *(const f32x4*)(p.wsp + (size_t)i * 8 + 4);
            *(u32x4*)(WSB + (size_t)i * 8) = (u32x4){pk2(a[0], a[1]), pk2(a[2], a[3]), pk2(b[0], b[1]), pk2(b[2], b[3])};
        }
        if (gt < 1024) {
            const int pos = gt >> 4, i = gt & 15;
            const float inv = exp2f(-(float)i * (13.287712379549449f / 16.0f));
            const float ang = (float)pos * inv; float s, c; sincospif(ang * 0.3183098861837907f, &s, &c);
            ((float*)(ws + WS_ROPE))[gt * 2] = c; ((float*)(ws + WS_ROPE))[gt * 2 + 1] = s;
        }
    }
}

__device__ __forceinline__ void norm_phase(const float* xs, const float* cs, const float* g, const float* modl, int which, bf16_t* A1, int nrows, int tid) {
    const int lane = tid & 63, wave = tid >> 6;
    f32x4 gvv[4];
#pragma unroll
    for (int j = 0; j < 4; ++j) gvv[j] = *(const f32x4*)(g + 4 * lane + 256 * j);
    for (int row = blockIdx.x * 8 + wave; row < nrows; row += gridDim.x * 8) {
        const float* src = row < MX ? xs + (size_t)row * DM : cs + (size_t)(row - MX) * DM;
        const int bp = row < MX ? (row >> 12) : 8;
        const float* sh = modl + (size_t)bp * 6144 + which * 3 * 1024; const float* scl = sh + 1024;
        f32x4 v[4]; float ss = 0.f;
#pragma unroll
        for (int j = 0; j < 4; ++j) { v[j] = __builtin_nontemporal_load((const f32x4*)(src + 4 * lane + 256 * j)); ss += (v[j][0] * v[j][0] + v[j][1] * v[j][1]) + (v[j][2] * v[j][2] + v[j][3] * v[j][3]); }
        const float r = rsqrtf(wave_sum(ss) * (1.0f / 1024.0f) + 1e-6f);
#pragma unroll
        for (int j = 0; j < 4; ++j) {
            const f32x4 s1 = *(const f32x4*)(scl + 4 * lane + 256 * j), s0 = *(const f32x4*)(sh + 4 * lane + 256 * j);
            f32x4 y = v[j] * r * gvv[j]; y = y * (s1 + 1.0f) + s0;
            *(u32x2*)(A1 + (size_t)row * DM + 4 * lane + 256 * j) = (u32x2){pk2(y[0], y[1]), pk2(y[2], y[3])};
        }
    }
}

__device__ __forceinline__ void aux_phase(const Params& p, LAS unsigned char* lds, int tid) {
    unsigned char* ws = p.ws;
    const float* MOD = (const float*)(ws + WS_MOD);
    {
        const int gt = blockIdx.x * NTHREADS + tid, GT = gridDim.x * NTHREADS;
        float* GS = (float*)(ws + WS_GS);
        for (int i = gt; i < 2 * 2 * 9 * 1024; i += GT) {
            const int k = i & 1023, bp = (i >> 10) % 9, lw = i / 9216, l = lw >> 1, w = lw & 1;
            const float g = (w == 0 ? p.g1 : p.g2)[l * 1024 + k];
            GS[i] = g * (1.0f + MOD[(size_t)(l * 9 + bp) * 6144 + (w * 3 + 1) * 1024 + k]);
        }
    }
    LAS float* sh = (LAS float*)lds;
    for (int u = blockIdx.x; u < 156; u += gridDim.x) {
        int l, n0, which, N; const bf16_t* W; float* dst;
        if (u < 128) { l = u >> 6; n0 = (u & 63) * 64; which = 1; N = 4096; W = (const bf16_t*)(ws + WS_W1) + (size_t)l * 4096 * 1024; dst = (float*)(ws + WS_SHW) + (size_t)l * 9 * 4096; }
        else { l = 1; n0 = (u - 128) * 64; which = 0; N = NIN; W = (const bf16_t*)(ws + WS_WIN) + (size_t)NIN * 1024; dst = (float*)(ws + WS_SHW) + 131072; }
        for (int i = tid; i < 9 * 1024; i += NTHREADS) sh[(i >> 10) * 1032 + (i & 1023) + ((i & 1023) >> 7)] = MOD[(size_t)(l * 9 + (i >> 10)) * 6144 + which * 3 * 1024 + (i & 1023)];
        __syncthreads();
        const int col = tid >> 3, kg = tid & 7;
        float acc[9];
#pragma unroll
        for (int b = 0; b < 9; ++b) acc[b] = 0.f;
        const bf16_t* wp = W + (size_t)(n0 + col) * 1024 + kg * 128;
#pragma unroll 4
        for (int c = 0; c < 16; ++c) {
            const u32x4 v = *(const u32x4*)(wp + c * 8);
            float y[8]; unpack8(v, y);
#pragma unroll
            for (int e = 0; e < 8; ++e)
#pragma unroll
                for (int b = 0; b < 9; ++b) acc[b] += sh[b * 1032 + kg * 129 + c * 8 + e] * y[e];
        }
#pragma unroll
        for (int b = 0; b < 9; ++b) { float a = acc[b]; a += __shfl_xor(a, 1); a += __shfl_xor(a, 2); a += __shfl_xor(a, 4); if (kg == 0) dst[(size_t)b * N + n0 + col] = a; }
        __syncthreads();
    }
}

__device__ __forceinline__ void ctx_finish_phase(const Params& p, int tid) {
    unsigned char* ws = p.ws;
    const int lane = tid & 63, wave = tid >> 6;
    float* XC = (float*)(ws + WS_XC); const float* SL = (const float*)(ws + WS_SLAB);
    const float* gate = (const float*)(ws + WS_MOD) + (size_t)8 * 6144 + 5 * 1024;
    const float* gs = (const float*)(ws + WS_GS) + (size_t)(2 * 9 + 8) * 1024;
    bf16_t* A1 = (bf16_t*)(ws + WS_A1); float* RS1 = (float*)(ws + WS_RS) + MT;
    for (int row = blockIdx.x * 8 + wave; row < MC; row += gridDim.x * 8) {
        float ss = 0.f;
#pragma unroll
        for (int j = 0; j < 4; ++j) {
            const int col = 4 * lane + 256 * j; const size_t o = (size_t)row * DM + col;
            f32x4 a = *(const f32x4*)(SL + o);
#pragma unroll
            for (int ks = 1; ks < 4; ++ks) a += *(const f32x4*)(SL + (size_t)ks * MC * DM + o);
            const f32x4 x = *(const f32x4*)(XC + o) + *(const f32x4*)(gate + col) * a;
            *(f32x4*)(XC + o) = x;
            ss += (x[0] * x[0] + x[1] * x[1]) + (x[2] * x[2] + x[3] * x[3]);
            const f32x4 y = x * *(const f32x4*)(gs + col);
            *(u32x2*)(A1 + (size_t)(MX + row) * DM + col) = (u32x2){pk2(y[0], y[1]), pk2(y[2], y[3])};
        }
        ss = wave_sum(ss);
        if (lane == 0) RS1[MX + row] = ss;
    }
}

__device__ __forceinline__ int perm16(int row) { const int q = (row >> 2) & 3; const int q2 = (q == 1) ? 2 : (q == 2 ? 1 : q); return (row & ~15) | (q2 << 2) | (row & 3); }
template <bool PERMK, class F> __device__ __forceinline__ void post_transpose(const bf16_t* px, int c0, LAS unsigned short* Lt, int tid, F&& destrow) {
    u32x4 v[4];
#pragma unroll
    for (int j = 0; j < 4; ++j) { const int c = tid + j * NTHREADS; v[j] = *(const u32x4*)(px + (size_t)(c >> 4) * NIN + c0 + (c & 15) * 8); }
#pragma unroll
    for (int j = 0; j < 4; ++j) {
        const int c = tid + j * NTHREADS, row = c >> 4, ch = c & 15;
        const int pr = (PERMK ? perm16(row) : row) ^ (ch << 3);
        LAS unsigned short* d = Lt + (ch * 8) * 136 + pr;
        d[0] = (unsigned short)(v[j].x & 0xffff); d[136] = (unsigned short)(v[j].x >> 16); d[2 * 136] = (unsigned short)(v[j].y & 0xffff); d[3 * 136] = (unsigned short)(v[j].y >> 16);
        d[4 * 136] = (unsigned short)(v[j].z & 0xffff); d[5 * 136] = (unsigned short)(v[j].z >> 16); d[6 * 136] = (unsigned short)(v[j].w & 0xffff); d[7 * 136] = (unsigned short)(v[j].w >> 16);
    }
    __syncthreads();
#pragma unroll
    for (int j = 0; j < 4; ++j) {
        const int c = tid + j * NTHREADS, col = c >> 4, ch = c & 15;
        const u32x4 w = *(const LAS u32x4*)(Lt + col * 136 + ((ch * 8) ^ (((col >> 3) & 15) << 3)));
        *(u32x4*)(destrow(col) + ch * 8) = w;
    }
    __syncthreads();
}

__device__ __forceinline__ void post_phase(const Params& p, int l, LAS unsigned char* lds, int tid) {
    unsigned char* ws = p.ws;
    const bf16_t* PX = (const bf16_t*)(ws + WS_PX);
    bf16_t* QS = (bf16_t*)(ws + WS_QS); bf16_t* KS = (bf16_t*)(ws + WS_KS); bf16_t* VT = (bf16_t*)(ws + WS_VT);
    bf16_t* ZT = (bf16_t*)(ws + WS_ZT); bf16_t* ZTC = (bf16_t*)(ws + WS_ZTC); bf16_t* MIX = (bf16_t*)(ws + WS_MIX);
    LAS unsigned short* Lt = (LAS unsigned short*)lds;
    LAS float* ropeL = (LAS float*)(lds + 131072);
    for (int i = tid; i < 2048; i += NTHREADS) ropeL[i] = ((const float*)(ws + WS_ROPE))[i];
    __syncthreads();
    const int lane = tid & 63, wave = tid >> 6;
    unsigned* qctr = (unsigned*)(ws + 32768) + 64 * l;
    volatile LAS unsigned* qnext = (volatile LAS unsigned*)(lds + 139328);
    for (int u = blockIdx.x; u < 272 * 3; ) {
        const int part = u / 272, ci = u % 272;
        const bool isx = ci < 256;
        const int R0 = ci * 128;
        const int b = isx ? (ci >> 5) : ((ci - 256) >> 1);
        const int n0 = isx ? (ci & 31) * 128 : ((ci - 256) & 1) * 128;
        const int t0 = isx ? 256 + n0 : n0;
        const bf16_t* px = PX + (size_t)R0 * NIN;
        if (part == 0) {
            for (int it = 0; it < 5; ++it) {
                u32x4 v[4];
#pragma unroll
                for (int j = 0; j < 4; ++j) { const int task = (it * 4 + j) * NTHREADS + tid; const int tok = task / 80, rem = task - tok * 80; v[j] = *(const u32x4*)(px + (size_t)tok * NIN + rem * 8); }
#pragma unroll
                for (int j = 0; j < 4; ++j) {
                    const int task = (it * 4 + j) * NTHREADS + tid; const int tok = task / 80, rem = task - tok * 80, hh = rem >> 3, ch = rem & 7;
                    float y[8]; unpack8(v[j], y);
                    float ss = 0.f;
#pragma unroll
                    for (int e = 0; e < 8; ++e) ss += y[e] * y[e];
                    ss = sum8(ss);
                    const float r = rsqrtf(ss * (1.0f / 64.0f) + 1e-6f);
                    const float* gg = (hh < 8 ? p.qg : p.kg) + l * 64 + ch * 8;
                    const f32x4 g0 = *(const f32x4*)gg, g1 = *(const f32x4*)(gg + 4);
#pragma unroll
                    for (int e = 0; e < 4; ++e) { y[e] *= r * g0[e]; y[4 + e] *= r * g1[e]; }
                    float o[8];
                    if (isx) {
                        const int n = n0 + tok, pos = (ch < 4) ? (n >> 6) : (n & 63);
                        const LAS f32x4* rp = (const LAS f32x4*)(ropeL + (pos * 16 + (ch & 1) * 8) * 2);
                        const f32x4 t0v = rp[0], t1v = rp[1], t2v = rp[2], t3v = rp[3];
                        const float cs[8] = {t0v[0], t0v[2], t1v[0], t1v[2], t2v[0], t2v[2], t3v[0], t3v[2]};
                        const float sn[8] = {t0v[1], t0v[3], t1v[1], t1v[3], t2v[1], t2v[3], t3v[1], t3v[3]};
                        const bool second = (ch & 2) != 0;
#pragma unroll
                        for (int e = 0; e < 8; ++e) { const float pv = dpp_xor2(y[e]); o[e] = second ? (pv * sn[e] + y[e] * cs[e]) : (y[e] * cs[e] - pv * sn[e]); }
                    } else {
#pragma unroll
                        for (int e = 0; e < 8; ++e) o[e] = y[e];
                    }
                    bf16_t* d;
                    if (hh < 8) {
#pragma unroll
                        for (int e = 0; e < 8; ++e) o[e] *= QSCALE;
                        d = QS + ((size_t)(b * 8 + hh) * TKV + t0 + tok) * 64 + ch * 8;
                    } else d = KS + ((size_t)(b * 2 + (hh - 8)) * TKV + t0 + tok) * 64 + ch * 8;
                    *(u32x4*)d = (u32x4){pk2(o[0], o[1]), pk2(o[2], o[3]), pk2(o[4], o[5]), pk2(o[6], o[7])};
                }
            }
            post_transpose<true>(px, 640, Lt, tid, [&](int col) { return VT + ((size_t)(b * 2 + (col >> 6)) * 64 + (col & 63)) * TKV + t0; });
        } else if (part == 1) {
            for (int g = 0; g < 4; ++g) {
                if (isx) post_transpose<false>(px, 768 + g * 128, Lt, tid, [&](int col) { return ZT + ((size_t)((col >> 6) * 2048 + b * 256 + g * 64 + (col & 63))) * 4096 + n0; });
                else     post_transpose<false>(px, 768 + g * 128, Lt, tid, [&](int col) { return ZTC + ((size_t)(b * 256 + g * 64 + (col & 63))) * 512 + (col >> 6) * 256 + n0; });
            }
        } else {
            for (int it = 0; it < 2; ++it) {
                u32x4 v[4];
#pragma unroll
                for (int j = 0; j < 4; ++j) { const int task = (it * 4 + j) * NTHREADS + tid; v[j] = *(const u32x4*)(px + (size_t)(task >> 5) * NIN + 1536 + (task & 31) * 8); }
#pragma unroll
                for (int j = 0; j < 4; ++j) {
                    const int task = (it * 4 + j) * NTHREADS + tid; const int tok = task >> 5, c8 = task & 31;
                    float y[8]; unpack8(v[j], y);
                    float ss = 0.f;
#pragma unroll
                    for (int e = 0; e < 8; ++e) { y[e] = gelu_t(y[e]); ss += y[e] * y[e]; }
                    ss = sum8(ss);
                    const float r = rsqrtf(ss * (1.0f / 64.0f) + 1e-6f);
                    const float* gg = p.vg + l * 256 + c8 * 8;
                    const f32x4 g0 = *(const f32x4*)gg, g1 = *(const f32x4*)(gg + 4);
                    LAS unsigned short* d = Lt + (c8 * 8) * 136 + (tok ^ ((c8 & 15) << 3));
#pragma unroll
                    for (int e = 0; e < 4; ++e) { d[e * 136] = f2bf(y[e] * r * g0[e]); d[(4 + e) * 136] = f2bf(y[4 + e] * r * g1[e]); }
                }
            }
            __syncthreads();
            {
                const int h = wave >> 1, db = wave & 1, r32 = lane & 31, hi = lane >> 5;
                const int col = h * 64 + db * 32 + r32, swz = ((col >> 3) & 15) << 3;
                bf16x8 bfr[8];
#pragma unroll
                for (int s = 0; s < 8; ++s) bfr[s] = *(const LAS bf16x8*)(Lt + col * 136 + ((16 * s + 8 * hi) ^ swz));
                const bf16_t* wsb = (const bf16_t*)(ws + WS_WSB) + (size_t)(l * 4 + h) * 128 * 128;
                const float* bs = p.bsp + (size_t)(l * 4 + h) * 128;
                for (int pb = 0; pb < 4; ++pb) {
                    unsigned short uu[16];
#pragma unroll
                    for (int e = 0; e < 16; ++e) uu[e] = px[(size_t)(pb * 32 + (e & 3) + 8 * (e >> 2) + 4 * hi) * NIN + 1280 + col];
                    f32x16 acc;
#pragma unroll
                    for (int e = 0; e < 16; ++e) acc[e] = 0.f;
#pragma unroll
                    for (int s = 0; s < 8; ++s) {
                        const bf16x8 a = *(const bf16x8*)(wsb + (size_t)(pb * 32 + r32) * 128 + 16 * s + 8 * hi);
                        acc = __builtin_amdgcn_mfma_f32_32x32x16_bf16(a, bfr[s], acc, 0, 0, 0);
                    }
#pragma unroll
                    for (int e = 0; e < 16; ++e) {
                        const int pp = pb * 32 + (e & 3) + 8 * (e >> 2) + 4 * hi;
                        MIX[(size_t)(R0 + pp) * KOUT + 768 + col] = f2bf(gelu_t(bf2f(uu[e])) * (acc[e] + bs[pp]));
                    }
                }
            }
            __syncthreads();
        }
        if (tid == 0) *qnext = gridDim.x + __hip_atomic_fetch_add(qctr, 1u, __ATOMIC_RELAXED, __HIP_MEMORY_SCOPE_AGENT);
        __syncthreads();
        u = (int)*qnext;
        __syncthreads();
    }
}

__device__ __forceinline__ void fft_phase(const Params& p, LAS unsigned char* lds, int tid) {
    unsigned char* ws = p.ws;
    const bf16_t* ZT = (const bf16_t*)(ws + WS_ZT); bf16_t* MIX = (bf16_t*)(ws + WS_MIX);
    const bf16_t* FA = (const bf16_t*)(ws + WS_FA); const bf16_t* FB = (const bf16_t*)(ws + WS_FB); const float* TW = (const float*)(ws + WS_TW);
    LAS unsigned short* Z = (LAS unsigned short*)lds;
    const int lane = tid & 63, w = tid >> 6, r32 = lane & 31, hi = lane >> 5;
    for (int u = blockIdx.x; u < 256; u += gridDim.x) {
        const int b = u >> 5, g = (u >> 3) & 3, cb = u & 7;
        {
            u32x4 v[16];
#pragma unroll
            for (int j = 0; j < 16; ++j) v[j] = *(const u32x4*)(ZT + ((size_t)((j >> 3) * 2048 + b * 256 + g * 64 + cb * 8 + (j & 7))) * 4096 + tid * 8);
#pragma unroll
            for (int j = 0; j < 16; ++j) *(LAS u32x4*)(Z + j * 4096 + tid * 8) = v[j];
        }
        __syncthreads();
        LAS unsigned short* Zr = Z + w * 4096; LAS unsigned short* Zi = Z + (8 + w) * 4096;
        for (int nh = 0; nh < 2; ++nh) {
            const int n2 = nh * 32 + r32;
            int two = (n2 * 64 + 4 * hi) * 2; asm volatile("" : "+v"(two));
            const GAS float* twp = (const GAS float*)TW + two;
            f32x4 tw0[2][4], tw1[2][4];
#pragma unroll
            for (int rg = 0; rg < 4; ++rg) { tw0[0][rg] = *(const GAS f32x4*)(twp + (8 * rg) * 2); tw1[0][rg] = *(const GAS f32x4*)(twp + (8 * rg) * 2 + 4); }
            bf16x8 bfA[8];
#pragma unroll
            for (int s = 0; s < 8; ++s) {
                const LAS unsigned short* q = Z + ((s >> 2) * 8 + w) * 4096 + (16 * (s & 3) + 8 * hi) * 64 + n2;
                u32x4 t;
                t.x = (unsigned)q[0] | ((unsigned)q[64] << 16); t.y = (unsigned)q[128] | ((unsigned)q[192] << 16);
                t.z = (unsigned)q[256] | ((unsigned)q[320] << 16); t.w = (unsigned)q[384] | ((unsigned)q[448] << 16);
                bfA[s] = __builtin_bit_cast(bf16x8, t);
            }
            f32x16 acc[4];
            int fao = r32 * 128 + 8 * hi; asm volatile("" : "+v"(fao));
            const GAS bf16_t* fap = (const GAS bf16_t*)FA + fao;
#pragma unroll
            for (int mt = 0; mt < 4; ++mt) {
#pragma unroll
                for (int e = 0; e < 16; ++e) acc[mt][e] = 0.f;
#pragma unroll
                for (int s = 0; s < 8; ++s) {
                    const bf16x8 a = *(const GAS bf16x8*)(fap + mt * 32 * 128 + 16 * s);
                    acc[mt] = __builtin_amdgcn_mfma_f32_32x32x16_bf16(a, bfA[s], acc[mt], 0, 0, 0);
                }
                asm volatile("" ::: "memory");
            }
#pragma unroll
            for (int rg = 0; rg < 4; ++rg) { tw0[1][rg] = *(const GAS f32x4*)(twp + (32 + 8 * rg) * 2); tw1[1][rg] = *(const GAS f32x4*)(twp + (32 + 8 * rg) * 2 + 4); }
#pragma unroll
            for (int mt = 0; mt < 2; ++mt)
#pragma unroll
                for (int rg = 0; rg < 4; ++rg) {
                    const int k1b = 32 * mt + 8 * rg + 4 * hi;
                    const f32x4 t0 = tw0[mt][rg], t1 = tw1[mt][rg];
                    const float ct[4] = {t0[0], t0[2], t1[0], t1[2]}, st[4] = {t0[1], t0[3], t1[1], t1[3]};
#pragma unroll
                    for (int e = 0; e < 4; ++e) {
                        const int k1 = k1b + e; const float tr = acc[mt][4 * rg + e], ti = acc[mt + 2][4 * rg + e];
                        const int pos = k1 * 64 + ((((n2 >> 3) ^ (k1 & 3)) << 3) | (n2 & 7));
                        Zr[pos] = f2bf(tr * ct[e] + ti * st[e]); Zi[pos] = f2bf(ti * ct[e] - tr * st[e]);
                    }
                }
        }
        __syncthreads();
        f32x16 y[2][2];
#pragma unroll
        for (int nt = 0; nt < 2; ++nt) {
            const int k1 = nt * 32 + r32;
            bf16x8 bfB[8];
#pragma unroll
            for (int s = 0; s < 8; ++s) bfB[s] = *(const LAS bf16x8*)(Z + ((s >> 2) * 8 + w) * 4096 + k1 * 64 + (((2 * (s & 3) + hi) ^ (k1 & 3)) << 3));
            int fbo = r32 * 128 + 8 * hi; asm volatile("" : "+v"(fbo));
            const GAS bf16_t* fbp = (const GAS bf16_t*)FB + fbo;
#pragma unroll
            for (int mt = 0; mt < 2; ++mt) {
#pragma unroll
                for (int e = 0; e < 16; ++e) y[mt][nt][e] = 0.f;
#pragma unroll
                for (int s = 0; s < 8; ++s) {
                    const bf16x8 a = *(const GAS bf16x8*)(fbp + mt * 32 * 128 + 16 * s);
                    y[mt][nt] = __builtin_amdgcn_mfma_f32_32x32x16_bf16(a, bfB[s], y[mt][nt], 0, 0, 0);
                }
                asm volatile("" ::: "memory");
            }
        }
        __syncthreads();
#pragma unroll
        for (int mt = 0; mt < 2; ++mt)
#pragma unroll
            for (int nt = 0; nt < 2; ++nt)
#pragma unroll
                for (int e = 0; e < 16; ++e) {
                    const int k2 = 32 * mt + (e & 3) + 8 * (e >> 2) + 4 * hi, k = nt * 32 + r32 + 64 * k2;
                    Z[k * 8 + w] = f2bf(y[mt][nt][e]);
                }
        __syncthreads();
#pragma unroll
        for (int j = 0; j < 8; ++j) {
            const int k = j * NTHREADS + tid;
            const u32x4 v = *(const LAS u32x4*)(Z + k * 8);
            bf16_t* d = MIX + (size_t)(b * SEQ + k) * KOUT + 512 + g * 64 + cb * 8;
            *(u32x4*)d = v;
        }
        asm volatile("s_waitcnt lgkmcnt(0)" ::: "memory"); __builtin_amdgcn_s_barrier(); asm volatile("" ::: "memory");
    }
}

__device__ __forceinline__ void attn_unit(const bf16_t* Q, const bf16_t* K, const bf16_t* Vt, int ntiles, int nrows, bf16_t* O, float negM, LAS unsigned char* lds, int tid) {
    const int lane = tid & 63, w = tid >> 6, r32 = lane & 31, hi = lane >> 5;
    const int row0 = w * 64 + r32, row1 = row0 + 32;
    bf16x8 qa[4], qb[4];
    {
        const bf16_t* qp0 = Q + (size_t)min(row0, nrows - 1) * 64 + hi * 8;
        const bf16_t* qp1 = Q + (size_t)min(row1, nrows - 1) * 64 + hi * 8;
#pragma unroll
        for (int s = 0; s < 4; ++s) { qa[s] = *(const bf16x8*)(qp0 + 16 * s); qb[s] = *(const bf16x8*)(qp1 + 16 * s); }
    }
    LAS unsigned char* qlds = lds + 40960 + w * 4096 + lane * 16;
#pragma unroll
    for (int s = 0; s < 4; ++s) *(LAS bf16x8*)(qlds + s * 1024) = qb[s];
    f32x16 oa0, oa1, ob0, ob1;
#pragma unroll
    for (int e = 0; e < 16; ++e) { oa0[e] = 0.f; oa1[e] = 0.f; ob0[e] = 0.f; ob1[e] = 0.f; }
    float lsa = 0.f, lsb = 0.f;
    const int srow = tid >> 3, sch = tid & 7;
    const bf16_t* kg = K + srow * 64 + sch * 8;
    const bf16_t* vg = Vt + (size_t)srow * TKV + sch * 8;
    const int soff = srow * 144 + sch * 16;
    u32x4 kr = *(const u32x4*)kg, vr = *(const u32x4*)vg;
    *(LAS u32x4*)(lds + soff) = kr; *(LAS u32x4*)(lds + 9216 + soff) = vr;
    __syncthreads();
    const int foff = r32 * 144 + hi * 16;
#define ATT_SCORES(QF, PF, LS) do { \
        f32x16 p0, p1; \
        _Pragma("unroll") for (int e = 0; e < 16; ++e) { p0[e] = negM; p1[e] = negM; } \
        _Pragma("unroll") for (int s = 0; s < 4; ++s) { p0 = __builtin_amdgcn_mfma_f32_32x32x16_bf16(kf0[s], QF[s], p0, 0, 0, 0); p1 = __builtin_amdgcn_mfma_f32_32x32x16_bf16(kf1[s], QF[s], p1, 0, 0, 0); } \
        float ls = 0.f; \
        _Pragma("unroll") for (int e = 0; e < 16; ++e) { p0[e] = __builtin_amdgcn_exp2f(p0[e]); p1[e] = __builtin_amdgcn_exp2f(p1[e]); ls += p0[e] + p1[e]; } \
        LS += ls; \
        _Pragma("unroll") for (int hf = 0; hf < 2; ++hf) { u32x4 a, c; \
            a.x = pk2(p0[8 * hf + 0], p0[8 * hf + 1]); a.y = pk2(p0[8 * hf + 2], p0[8 * hf + 3]); a.z = pk2(p0[8 * hf + 4], p0[8 * hf + 5]); a.w = pk2(p0[8 * hf + 6], p0[8 * hf + 7]); \
            c.x = pk2(p1[8 * hf + 0], p1[8 * hf + 1]); c.y = pk2(p1[8 * hf + 2], p1[8 * hf + 3]); c.z = pk2(p1[8 * hf + 4], p1[8 * hf + 5]); c.w = pk2(p1[8 * hf + 6], p1[8 * hf + 7]); \
            PF[hf] = __builtin_bit_cast(bf16x8, a); PF[2 + hf] = __builtin_bit_cast(bf16x8, c); } \
    } while (0)
    asm volatile("" : "+s"(ntiles));
#pragma clang loop unroll(disable)
    for (int t = 0; t < ntiles; ++t) {
        const int cur = t & 1;
        const bool more = (t + 1 < ntiles);
        if (more) { kr = *(const u32x4*)(kg + (size_t)(t + 1) * 4096); vr = *(const u32x4*)(vg + (size_t)(t + 1) * 64); }
        const LAS unsigned char* kb = lds + cur * 18432 + foff;
        const LAS unsigned char* vb = kb + 9216;
        bf16x8 kf0[4], kf1[4];
#pragma unroll
        for (int s = 0; s < 4; ++s) { kf0[s] = *(const LAS bf16x8*)(kb + s * 32); kf1[s] = *(const LAS bf16x8*)(kb + 32 * 144 + s * 32); }
        bf16x8 pa[4], pb[4];
        ATT_SCORES(qa, pa, lsa);
        bf16x8 qc[4];
#pragma unroll
        for (int s = 0; s < 4; ++s) qc[s] = *(const LAS bf16x8*)(qlds + s * 1024);
        ATT_SCORES(qc, pb, lsb);
#pragma unroll
        for (int s = 0; s < 4; ++s) {
            const bf16x8 v0 = *(const LAS bf16x8*)(vb + s * 32), v1 = *(const LAS bf16x8*)(vb + 32 * 144 + s * 32);
            oa0 = __builtin_amdgcn_mfma_f32_32x32x16_bf16(v0, pa[s], oa0, 0, 0, 0);
            oa1 = __builtin_amdgcn_mfma_f32_32x32x16_bf16(v1, pa[s], oa1, 0, 0, 0);
            ob0 = __builtin_amdgcn_mfma_f32_32x32x16_bf16(v0, pb[s], ob0, 0, 0, 0);
            ob1 = __builtin_amdgcn_mfma_f32_32x32x16_bf16(v1, pb[s], ob1, 0, 0, 0);
        }
        if (more) { *(LAS u32x4*)(lds + (cur ^ 1) * 18432 + soff) = kr; *(LAS u32x4*)(lds + (cur ^ 1) * 18432 + 9216 + soff) = vr; }
        __syncthreads();
    }
#undef ATT_SCORES
#define ATT_STORE(O0, O1, LS, ROW) do { if ((ROW) < nrows) { float l = LS; l += __shfl_xor(l, 32); const float inv = 1.0f / l; \
        bf16_t* op = O + (size_t)(ROW) * KOUT + 4 * hi; \
        _Pragma("unroll") for (int rg = 0; rg < 4; ++rg) { \
            *(u32x2*)(op + 8 * rg) = (u32x2){pk2(O0[4 * rg] * inv, O0[4 * rg + 1] * inv), pk2(O0[4 * rg + 2] * inv, O0[4 * rg + 3] * inv)}; \
            *(u32x2*)(op + 32 + 8 * rg) = (u32x2){pk2(O1[4 * rg] * inv, O1[4 * rg + 1] * inv), pk2(O1[4 * rg + 2] * inv, O1[4 * rg + 3] * inv)}; } } } while (0)
    ATT_STORE(oa0, oa1, lsa, row0);
    ATT_STORE(ob0, ob1, lsb, row1);
#undef ATT_STORE
}

__device__ __forceinline__ void attn_phase(const Params& p, int l, LAS unsigned char* lds, int tid) {
    unsigned char* ws = p.ws;
    const bf16_t* QS = (const bf16_t*)(ws + WS_QS); const bf16_t* KS = (const bf16_t*)(ws + WS_KS); const bf16_t* VT = (const bf16_t*)(ws + WS_VT);
    bf16_t* MIX = (bf16_t*)(ws + WS_MIX);
    float mq = 0.f, mk = 0.f;
    for (int i = 0; i < 64; ++i) { mq = fmaxf(mq, fabsf(p.qg[l * 64 + i])); mk = fmaxf(mk, fabsf(p.kg[l * 64 + i])); }
    const float negM = -(8.0f * 1.4426950408889634f) * mq * mk * 1.02f - 0.25f;
    const int nunits = 512 + (l == 0 ? 64 : 0);
    for (int u = blockIdx.x; u < nunits; u += gridDim.x) {
        const bool lat = u < 512;
        const int v = lat ? u : u - 512;
        const int b = lat ? (v >> 6) : (v >> 3), head = lat ? ((v >> 3) & 7) : (v & 7), qb = v & 7, kvh = head >> 2;
        const size_t qrow = (size_t)(b * 8 + head) * TKV + (lat ? 256 + qb * 512 : 0);
        const size_t orow = lat ? (size_t)(b * SEQ + qb * 512) : (size_t)(MX + b * CTX);
        attn_unit(QS + qrow * 64, KS + (size_t)(b * 2 + kvh) * TKV * 64, VT + (size_t)(b * 2 + kvh) * 64 * TKV, lat ? TKV / 64 : CTX / 64, lat ? 512 : 256,
                  MIX + orow * KOUT + head * 64, negM, lds, tid);
    }
}

#ifdef SKIP_GEMM
#define GEMMCALL if (0)
#else
#define GEMMCALL
#endif
__global__ void __launch_bounds__(NTHREADS, 2) mega(Params p) {
    extern __shared__ __attribute__((aligned(16))) unsigned char lds_raw[];
    LAS unsigned char* lds = (LAS unsigned char*)lds_raw;
    cg::grid_group grid = cg::this_grid();
    int tid = threadIdx.x; const int G = gridDim.x;
#define FRESH_TID() asm volatile("" : "+v"(tid))
    unsigned char* ws = p.ws;
    volatile LAS unsigned* xst = (volatile LAS unsigned*)(lds + LDS_BYTES - 64);
    if (tid < 16) xst[tid] = 0u;
    __syncthreads();
    XcdBarrier xb = xcd_barrier_post((unsigned*)(ws + WS_CTL) + 1024, xst);
    bf16_t* A1 = (bf16_t*)(ws + WS_A1); bf16_t* PX = (bf16_t*)(ws + WS_PX); bf16_t* MIX = (bf16_t*)(ws + WS_MIX); bf16_t* H = (bf16_t*)(ws + WS_H);
    float* XC = (float*)(ws + WS_XC);
#define GBAR() do { for (int rep = 0; rep < REP_BAR; ++rep) xcd_barrier(xb); } while (0)

#ifndef SKIP_PREP
    for (int rep = 0; rep < REP_PREP; ++rep) { FRESH_TID(); prep_phase(p, lds, tid, rep == 0 ? 31 : PREP_PROBE_MASK); }
#endif
    grid.sync();

    const float* GS = (const float*)(ws + WS_GS); float* RS = (float*)(ws + WS_RS);
    for (int l = 0; l < 2; ++l) {
        const float* modl = (const float*)(ws + WS_MOD) + (size_t)l * 9 * 6144;
        const float* xs = l == 0 ? p.x : p.out; const float* cs = l == 0 ? p.ctx : XC;
        const int Mres = l == 0 ? MT : MX;
        if (l == 0) {
            for (int rep = 0; rep < REP_NORM; ++rep) { FRESH_TID(); norm_phase(xs, cs, p.g1 + l * DM, modl, 0, A1, MT, tid); }
            FRESH_TID(); aux_phase(p, lds, tid);
            GBAR();
        }
        {
            pg8::Gemm g{A1, (const bf16_t*)(ws + WS_WIN) + (size_t)l * NIN * 1024, MT, NIN, 1024}; pg8::StaticOrder S; S.init(MT, NIN, G, (int)blockIdx.x);
            if (l == 0) { EpiStore<0> E{PX, NIN, 256}; GEMMCALL pg8::gemm_phase<EpiStore<0>, pg8::StaticOrder, true, true>(lds, g, S, E); }
            else { EpiStoreN<0> E{PX, NIN, RS + MT, (const float*)(ws + WS_SHW) + 131072, NIN}; GEMMCALL pg8::gemm_phase<EpiStoreN<0>, pg8::StaticOrder, true, true>(lds, g, S, E); }
        }
        GBAR();
        for (int rep = 0; rep < REP_POST; ++rep) { FRESH_TID(); post_phase(p, l, lds, tid); }
        GBAR();
        {
            for (int rep = 0; rep < REP_FOUR; ++rep) { FRESH_TID(); fft_phase(p, lds, tid); }
            if (l == 0) {
                pg8::Gemm g{(const bf16_t*)(ws + WS_CTC), (const bf16_t*)(ws + WS_ZTC), 256, 2048, 512}; pg8::StaticOrder S; S.init(256, 2048, G, (int)blockIdx.x);
                EpiStore<0> E{MIX + (size_t)MX * KOUT + 512, KOUT, (size_t)256 * KOUT};
                GEMMCALL pg8::gemm_phase<EpiStore<0>, pg8::StaticOrder, true, true>(lds, g, S, E);
            }
            __syncthreads();
            for (int rep = 0; rep < REP_ATTN; ++rep) { FRESH_TID(); attn_phase(p, l, lds, tid); }
        }
        GBAR();
        {
            pg8::Gemm g{MIX, (const bf16_t*)(ws + WS_WOUT) + (size_t)l * 1024 * KOUT, Mres, 1024, KOUT}; pg8::StaticOrder S; S.init(Mres, 1024, G, (int)blockIdx.x);
            EpiResid2 E{xs, cs, p.out, XC, modl + 2 * 1024, A1, GS + (size_t)(l * 2 + 1) * 9 * 1024, RS + (size_t)(l * 2) * MT};
            GEMMCALL pg8::gemm_phase<EpiResid2, pg8::StaticOrder, true, true>(lds, g, S, E);
        }
        GBAR();
        {
            pg8::Gemm g{A1, (const bf16_t*)(ws + WS_W1) + (size_t)l * 4096 * 1024, Mres, DFF, 1024}; pg8::StaticOrder S; S.init(Mres, DFF, G, (int)blockIdx.x);
            EpiStoreN<1> E{H, DFF, RS + (size_t)(l * 2) * MT, (const float*)(ws + WS_SHW) + (size_t)l * 9 * 4096, 4096};
            GEMMCALL pg8::gemm_phase<EpiStoreN<1>, pg8::StaticOrder, true, true>(lds, g, S, E);
        }
        GBAR();
        {
            pg8::Gemm g{H, (const bf16_t*)(ws + WS_W2) + (size_t)l * 1024 * 4096, Mres, 1024, DFF}; pg8::StaticOrder S; S.init(Mres, 1024, G, (int)blockIdx.x);
            if (l == 0) {
                pg8::StaticOrder Sx; Sx.init(MX, 1024, G, (int)blockIdx.x);
                EpiResid2 E{p.out, XC, p.out, XC, modl + 5 * 1024, A1, GS + (size_t)(2) * 9 * 1024, RS + MT}; GEMMCALL pg8::gemm_phase<EpiResid2, pg8::StaticOrder, true, true>(lds, g, Sx, E);
                for (int sub = (int)blockIdx.x; sub < 128; sub += G) {
                    const int ks = sub & 3, un = sub >> 2;
                    pg8::Gemm g2{H + (size_t)MX * DFF + ks * 1024, (const bf16_t*)(ws + WS_W2) + ks * 1024, MC, 1024, 1024, DFF};
                    OneUnit S2{true, un >> 2, un & 3};
                    EpiSlab E2{(float*)(ws + WS_SLAB) + (size_t)ks * MC * DM};
                    GEMMCALL pg8::gemm_phase<EpiSlab, OneUnit, true, true>(lds, g2, S2, E2);
                }
            }
            else { EpiResid E{p.out, XC, p.out, XC, modl + 5 * 1024}; GEMMCALL pg8::gemm_phase<EpiResid, pg8::StaticOrder, true, true>(lds, g, S, E); }
        }
        if (l == 0) { GBAR(); FRESH_TID(); ctx_finish_phase(p, tid); GBAR(); }
    }
}

extern "C" void kernel_launch(void* const* d_in, const int* in_sizes, int n_in, void* d_out, int out_size,
                              void* d_ws, size_t ws_size, hipStream_t stream) {
    static int grid_blocks = 0;
    if (!grid_blocks) {
        int dev = 0, cus = 0, per_cu = 0;
        hipGetDevice(&dev);
        hipDeviceGetAttribute(&cus, hipDeviceAttributeMultiprocessorCount, dev);
        hipFuncSetAttribute((const void*)mega, hipFuncAttributeMaxDynamicSharedMemorySize, LDS_BYTES);
        hipOccupancyMaxActiveBlocksPerMultiprocessor(&per_cu, (const void*)mega, NTHREADS, LDS_BYTES);
        if (per_cu < 1) fprintf(stderr, "kernel_launch: occupancy query reports %d workgroups per CU\n", per_cu);
        grid_blocks = cus;
        if (ws_size < WS_END) fprintf(stderr, "kernel_launch: workspace too small: %zu < %zu\n", ws_size, (size_t)WS_END);
    }
    Params p{};
    p.x = (const float*)d_in[0]; p.c = (const float*)d_in[1]; p.ctx = (const float*)d_in[2]; p.cctx = (const float*)d_in[3];
    p.w_ada = (const float*)d_in[4]; p.b_ada = (const float*)d_in[5]; p.g1 = (const float*)d_in[6]; p.g2 = (const float*)d_in[7];
    p.w_in = (const float*)d_in[8]; p.qg = (const float*)d_in[9]; p.kg = (const float*)d_in[10]; p.vg = (const float*)d_in[11];
    p.wsp = (const float*)d_in[12]; p.bsp = (const float*)d_in[13]; p.w_out = (const float*)d_in[14]; p.w1 = (const float*)d_in[15]; p.w2 = (const float*)d_in[16];
    p.out = (float*)d_out; p.ws = (unsigned char*)d_ws;
    hipMemsetAsync(d_ws, 0, WS_MOD + (size_t)2 * 9 * 6144 * sizeof(float), stream);
    void* args[] = {&p};
    hipError_t e = hipLaunchCooperativeKernel((void*)mega, dim3(grid_blocks), dim3(NTHREADS), args, LDS_BYTES, stream);
    if (e != hipSuccess) fprintf(stderr, "cooperative launch failed: %s (grid %d)\n", hipGetErrorString(e), grid_blocks);
}
```
